# Optimizing an MI355X kernel written in HIP

```python
import jax, jax.numpy as jnp
from jax import lax
import numpy as np

D_MODEL = 1024
BATCH = 4
SEQ = 4096
DEPTH = 2
DEC_BATCH = 4
DEC_SEQ = 8192
PAST_LEN = 128

N_MEM = 256
EPS = 1e-6
ROPE_THETA = 500000.0
Q_BLOCK = 128

A_HEADS = 8
A_HEAD_DIM = 64
A_WIDTH = A_HEADS * A_HEAD_DIM
A_ROPE_DIM = A_HEAD_DIM // 4
DILATED_BRANCHES = ((128, 1), (512, 4), (2048, 16))

B_HEADS = 8
B_NOPE_DIM = 64
B_ROPE_DIM = 32
B_QK_DIM = B_NOPE_DIM + B_ROPE_DIM
B_V_DIM = 64
B_WIDTH = B_HEADS * B_V_DIM
Q_LORA = 256
KV_LORA = 128

MIX_WIDTH = A_WIDTH + B_WIDTH
IN_SPLITS = (A_WIDTH, 2 * A_WIDTH, 3 * A_WIDTH, 3 * A_WIDTH + Q_LORA, 3 * A_WIDTH + Q_LORA + KV_LORA)
IN_COLS = 3 * A_WIDTH + Q_LORA + KV_LORA + B_ROPE_DIM

M_HEADS = 4
M_HEAD_DIM = 128
M_WIDTH = M_HEADS * M_HEAD_DIM

D_FF = 4 * D_MODEL

kernel_name = 'hybrid_dilated_mla_memory_encoder'


def rmsnorm(x, g):
    xf = x.astype(jnp.float32)
    y = xf * lax.rsqrt(jnp.mean(xf * xf, axis=-1, keepdims=True) + EPS)
    return (y * g.astype(jnp.float32)).astype(x.dtype)


def rope(x, pos):
    r = x.shape[-1]
    inv = ROPE_THETA ** (-jnp.arange(0, r, 2, dtype=jnp.float32) / r)
    ang = pos.astype(jnp.float32)[:, None] * inv[None, :]
    cos = jnp.cos(ang)[:, None, :]
    sin = jnp.sin(ang)[:, None, :]
    xf = x.astype(jnp.float32)
    x1, x2 = xf[..., : r // 2], xf[..., r // 2:]
    return jnp.concatenate([x1 * cos - x2 * sin, x2 * cos + x1 * sin], axis=-1).astype(x.dtype)


def partial_rope(x, pos, rdim):
    return jnp.concatenate([rope(x[..., :rdim], pos), x[..., rdim:]], axis=-1)


def dilated_mixture_attention(q, k, v):
    b, s, h, dh = q.shape
    nblk = s // Q_BLOCK
    q_blocks = q.reshape(b, nblk, Q_BLOCK, h, dh).transpose(1, 0, 2, 3, 4)
    starts = jnp.arange(nblk, dtype=jnp.int32) * Q_BLOCK
    local = jnp.arange(Q_BLOCK, dtype=jnp.int32)
    offsets = [jnp.asarray(np.arange(-(w // 2), w // 2 + 1, d), dtype=jnp.int32) for w, d in DILATED_BRANCHES]

    def one_block(args):
        q_blk, start = args
        qpos = start + local
        maxes, dens, nums = [], [], []
        for offs in offsets:
            idx = qpos[:, None] + offs[None, :]
            valid = (idx >= 0) & (idx < s)
            idx = jnp.clip(idx, 0, s - 1)
            k_g = k[:, idx]
            v_g = v[:, idx]
            sc = jnp.einsum('bqhd,bqkhd->bhqk', q_blk, k_g).astype(jnp.float32)
            sc = jnp.where(valid[None, None], sc, -jnp.inf)
            mx = jnp.max(sc, axis=-1)
            p = jnp.exp(sc - mx[..., None])
            maxes.append(mx)
            dens.append(jnp.sum(p, axis=-1))
            nums.append(jnp.einsum('bhqk,bqkhd->bhqd', p, v_g.astype(jnp.float32)))
        m_all = jnp.max(jnp.stack(maxes), axis=0)
        wts = [jnp.exp(mx - m_all) for mx in maxes]
        den = sum(wi * di for wi, di in zip(wts, dens))
        num = sum(wi[..., None] * ni for wi, ni in zip(wts, nums))
        out = num / den[..., None]
        return out.transpose(0, 2, 1, 3).astype(q.dtype)

    out = lax.map(one_block, (q_blocks, starts))
    return out.transpose(1, 0, 2, 3, 4).reshape(b, s, h, dh)


def blocked_dense_attention(q, k, v):
    b, s, h, dq = q.shape
    nblk = s // Q_BLOCK
    q_blocks = q.reshape(b, nblk, Q_BLOCK, h, dq).transpose(1, 0, 2, 3, 4)

    def one_block(q_blk):
        sc = jnp.einsum('bqhd,bkhd->bhqk', q_blk, k).astype(jnp.float32)
        p = jax.nn.softmax(sc, axis=-1)
        return jnp.einsum('bhqk,bkhd->bqhd', p.astype(v.dtype), v)

    out = lax.map(one_block, q_blocks)
    return out.transpose(1, 0, 2, 3, 4).reshape(b, s, h, v.shape[-1])


def encoder_trunk(x, mem, params):
    (norm_mix_g, w_in, a_q_norm_g, a_k_norm_g, b_cq_norm_g, b_ckv_norm_g, w_uq, w_ukv,
     b_q_norm_g, b_k_norm_g, a_out_norm_g, b_out_norm_g, w_out,
     norm_mem_g, mem_kv_norm_g, m_wq, m_wkv, m_q_norm_g, m_k_norm_g, m_wo,
     norm_ffn_g, w_ff1, w_ff2) = params
    bsz, s, _ = x.shape
    pos = jnp.arange(s, dtype=jnp.int32)
    for l in range(DEPTH):
        h = rmsnorm(x, norm_mix_g[l])
        proj = h @ w_in[l]
        qa, ka, va, cq, ckv, kr = jnp.split(proj, IN_SPLITS, axis=-1)

        qa = qa.reshape(bsz, s, A_HEADS, A_HEAD_DIM)
        ka = ka.reshape(bsz, s, A_HEADS, A_HEAD_DIM)
        va = va.reshape(bsz, s, A_HEADS, A_HEAD_DIM)
        qa = partial_rope(rmsnorm(qa, a_q_norm_g[l]), pos, A_ROPE_DIM) * (A_HEAD_DIM ** -0.5)
        ka = partial_rope(rmsnorm(ka, a_k_norm_g[l]), pos, A_ROPE_DIM)
        oa = dilated_mixture_attention(qa, ka, va).reshape(bsz, s, A_WIDTH)

        qb = (rmsnorm(cq, b_cq_norm_g[l]) @ w_uq[l]).reshape(bsz, s, B_HEADS, B_QK_DIM)
        kvb = (rmsnorm(ckv, b_ckv_norm_g[l]) @ w_ukv[l]).reshape(bsz, s, B_HEADS, B_NOPE_DIM + B_V_DIM)
        k_nope, vb = kvb[..., :B_NOPE_DIM], kvb[..., B_NOPE_DIM:]
        k_rope = jnp.broadcast_to(kr[:, :, None, :], (bsz, s, B_HEADS, B_ROPE_DIM))
        kb = jnp.concatenate([k_nope, k_rope], axis=-1)
        qb = rmsnorm(qb, b_q_norm_g[l])
        kb = rmsnorm(kb, b_k_norm_g[l])
        qb = jnp.concatenate([qb[..., :B_NOPE_DIM], rope(qb[..., B_NOPE_DIM:], pos)], axis=-1) * (B_QK_DIM ** -0.5)
        kb = jnp.concatenate([kb[..., :B_NOPE_DIM], rope(kb[..., B_NOPE_DIM:], pos)], axis=-1)
        ob = blocked_dense_attention(qb, kb, vb).reshape(bsz, s, B_WIDTH)

        mixed = jnp.concatenate([rmsnorm(oa, a_out_norm_g[l]), rmsnorm(ob, b_out_norm_g[l])], axis=-1)
        x = x + mixed @ w_out[l]

        h = rmsnorm(x, norm_mem_g[l])
        mm = rmsnorm(mem, mem_kv_norm_g[l])
        qm = (h @ m_wq[l]).reshape(bsz, s, M_HEADS, M_HEAD_DIM)
        kvm = (mm @ m_wkv[l]).reshape(bsz, N_MEM, 2, M_HEADS, M_HEAD_DIM)
        km, vm = kvm[:, :, 0], kvm[:, :, 1]
        qm = rmsnorm(qm, m_q_norm_g[l]) * (M_HEAD_DIM ** -0.5)
        km = rmsnorm(km, m_k_norm_g[l])
        sc = jnp.einsum('bqhd,bkhd->bhqk', qm, km).astype(jnp.float32)
        p = jax.nn.softmax(sc, axis=-1)
        om = jnp.einsum('bhqk,bkhd->bqhd', p.astype(vm.dtype), vm).reshape(bsz, s, M_WIDTH)
        x = x + om @ m_wo[l]

        h = rmsnorm(x, norm_ffn_g[l])
        x = x + jnp.square(jax.nn.relu(h @ w_ff1[l])) @ w_ff2[l]
    return x


def setup_inputs(seed: int = 0) -> dict:
    key = jax.random.key(seed)
    ks = jax.random.split(key, 32)

    def dense(k, shape, fan_in):
        return jax.random.normal(k, shape, jnp.float32) * (fan_in ** -0.5)

    def gain(k, shape):
        return 1.0 + 0.02 * jax.random.normal(k, shape, jnp.float32)

    L = DEPTH
    return {
        'x_prompt': jax.random.normal(ks[0], (BATCH, SEQ, D_MODEL), jnp.float32),
        'x_sample': jax.random.normal(ks[1], (DEC_BATCH, DEC_SEQ, D_MODEL), jnp.float32),
        'mem_prompt': jax.random.normal(ks[2], (BATCH, N_MEM, D_MODEL), jnp.float32),
        'mem_sample': jax.random.normal(ks[3], (DEC_BATCH, N_MEM, D_MODEL), jnp.float32),
        'norm_mix_g': gain(ks[4], (L, D_MODEL)),
        'w_in': dense(ks[5], (L, D_MODEL, IN_COLS), D_MODEL),
        'a_q_norm_g': gain(ks[6], (L, A_HEAD_DIM)),
        'a_k_norm_g': gain(ks[7], (L, A_HEAD_DIM)),
        'b_cq_norm_g': gain(ks[8], (L, Q_LORA)),
        'b_ckv_norm_g': gain(ks[9], (L, KV_LORA)),
        'w_uq': dense(ks[10], (L, Q_LORA, B_HEADS * B_QK_DIM), Q_LORA),
        'w_ukv': dense(ks[11], (L, KV_LORA, B_HEADS * (B_NOPE_DIM + B_V_DIM)), KV_LORA),
        'b_q_norm_g': gain(ks[12], (L, B_QK_DIM)),
        'b_k_norm_g': gain(ks[13], (L, B_QK_DIM)),
        'a_out_norm_g': gain(ks[14], (L, A_WIDTH)),
        'b_out_norm_g': gain(ks[15], (L, B_WIDTH)),
        'w_out': dense(ks[16], (L, MIX_WIDTH, D_MODEL), MIX_WIDTH),
        'norm_mem_g': gain(ks[17], (L, D_MODEL)),
        'mem_kv_norm_g': gain(ks[18], (L, D_MODEL)),
        'm_wq': dense(ks[19], (L, D_MODEL, M_WIDTH), D_MODEL),
        'm_wkv': dense(ks[20], (L, D_MODEL, 2 * M_WIDTH), D_MODEL),
        'm_q_norm_g': gain(ks[21], (L, M_HEAD_DIM)),
        'm_k_norm_g': gain(ks[22], (L, M_HEAD_DIM)),
        'm_wo': dense(ks[23], (L, M_WIDTH, D_MODEL), M_WIDTH),
        'norm_ffn_g': gain(ks[24], (L, D_MODEL)),
        'w_ff1': dense(ks[25], (L, D_MODEL, D_FF), D_MODEL),
        'w_ff2': dense(ks[26], (L, D_FF, D_MODEL), D_FF),
    }


def reference(x_prompt, x_sample, mem_prompt, mem_sample, norm_mix_g, w_in, a_q_norm_g, a_k_norm_g,
              b_cq_norm_g, b_ckv_norm_g, w_uq, w_ukv, b_q_norm_g, b_k_norm_g, a_out_norm_g, b_out_norm_g,
              w_out, norm_mem_g, mem_kv_norm_g, m_wq, m_wkv, m_q_norm_g, m_k_norm_g, m_wo,
              norm_ffn_g, w_ff1, w_ff2):
    params = (norm_mix_g, w_in, a_q_norm_g, a_k_norm_g, b_cq_norm_g, b_ckv_norm_g, w_uq, w_ukv,
              b_q_norm_g, b_k_norm_g, a_out_norm_g, b_out_norm_g, w_out,
              norm_mem_g, mem_kv_norm_g, m_wq, m_wkv, m_q_norm_g, m_k_norm_g, m_wo,
              norm_ffn_g, w_ff1, w_ff2)
    y_prompt = encoder_trunk(x_prompt, mem_prompt, params)
    y_sample = encoder_trunk(x_sample, mem_sample, params)
    return (y_prompt, y_sample)
```

```cpp
#include <hip/hip_runtime.h>
#include <hip/hip_cooperative_groups.h>
#include <cstdio>
#include <cstdint>
namespace cg = cooperative_groups;

#ifndef MK_ONE_LAUNCH
#define MK_ONE_LAUNCH 1
#endif

typedef unsigned short bf16_t;
typedef short bf16x8 __attribute__((ext_vector_type(8)));
typedef short s16x4 __attribute__((ext_vector_type(4)));
typedef float f32x4 __attribute__((ext_vector_type(4)));
typedef unsigned u32x4 __attribute__((ext_vector_type(4)));
typedef unsigned u32x2 __attribute__((ext_vector_type(2)));
typedef short v4i16_t __attribute__((ext_vector_type(4)));
#define LAS __attribute__((address_space(3)))

constexpr int T = 49152, TP = 16384, NMEMTOK = 2048;
constexpr int LDP = 2048;
constexpr int NPH_LAYER = 19, NPH = 2 * NPH_LAYER;
constexpr float EPS = 1e-6f;
constexpr float LOG2E = 1.4426950408889634f;

constexpr size_t W_IN_E = 2048ull * 1024, W_QKV_E = 2048ull * 384, W_OUT_E = 1024ull * 1024, W_MQ_E = 512ull * 1024,
                 W_MKV_E = 1024ull * 1024, W_MO_E = 1024ull * 512, W_1_E = 4096ull * 1024, W_2_E = 1024ull * 4096;
constexpr size_t WO_IN = 0, WO_QKV = WO_IN + W_IN_E, WO_OUT = WO_QKV + W_QKV_E, WO_MQ = WO_OUT + W_OUT_E, WO_MKV = WO_MQ + W_MQ_E,
                 WO_MO = WO_MKV + W_MKV_E, WO_1 = WO_MO + W_MO_E, WO_2 = WO_1 + W_1_E, W_LAYER_E = WO_2 + W_2_E;
constexpr size_t OFF_W = 0, OFF_CS = OFF_W + 2 * W_LAYER_E * 2, OFF_MM = OFF_CS + 8192ull * 16 * 8, OFF_KVM = OFF_MM + 2048ull * 1024 * 2,
                 OFF_RA = OFF_KVM + 2048ull * 1024 * 2, OFF_RB = OFF_RA + (size_t)T * 2048 * 2, WS_END = OFF_RB + (size_t)T * 2048 * 2;
constexpr int LDS_BYTES = 131072;

struct Params { const float* in[27]; float* out; unsigned char* ws; int ph_lo, ph_hi; };

extern __shared__ __attribute__((aligned(16))) unsigned char smem[];
typedef const __attribute__((address_space(4))) Params* PP;
struct Ctx { int tid, bid, nb; };

__device__ __forceinline__ unsigned cvtpk(float lo, float hi) { unsigned r; asm("v_cvt_pk_bf16_f32 %0, %1, %2" : "=v"(r) : "v"(lo), "v"(hi)); return r; }
__device__ __forceinline__ float bflo(unsigned u) { return __uint_as_float(u << 16); }
__device__ __forceinline__ float bfhi(unsigned u) { return __uint_as_float(u & 0xffff0000u); }
__device__ __forceinline__ void unpack8(const u32x4 v, float* f) {
#pragma unroll
    for (int i = 0; i < 4; ++i) { f[2 * i] = bflo(v[i]); f[2 * i + 1] = bfhi(v[i]); } }
__device__ __forceinline__ u32x4 pack8(const float* f) { u32x4 r; r.x = cvtpk(f[0], f[1]); r.y = cvtpk(f[2], f[3]); r.z = cvtpk(f[4], f[5]); r.w = cvtpk(f[6], f[7]); return r; }
__device__ __forceinline__ float shx(float v, int m, int lane) { return __int_as_float(__builtin_amdgcn_ds_bpermute((lane ^ m) << 2, __float_as_int(v))); }
__device__ __forceinline__ float shl(float v, int src) { return __int_as_float(__builtin_amdgcn_ds_bpermute(src << 2, __float_as_int(v))); }
__device__ __forceinline__ float wave_sum(float v, int lane) {
#pragma unroll
    for (int o = 32; o >= 1; o >>= 1) v += shx(v, o, lane);
    return v; }
__device__ __forceinline__ void seq_of_tok(int tok, int& seqbase, int& S) {
    if (tok < TP) { seqbase = tok & ~4095; S = 4096; } else { seqbase = TP + ((tok - TP) & ~8191); S = 8192; } }

namespace g8 {
constexpr int BM = 256, BK = 64, HALF = 128, HT = HALF * BK;
__device__ __forceinline__ int lds_byte(int r, int c) { int st = (r >> 4) * 2 + (c >> 5), rr = r & 15, cc = c & 31, ob = rr * 64 + cc * 2; return st * 1024 + (ob ^ (((ob >> 9) & 1) << 5)); }
__device__ __forceinline__ void stage_rc(int b, int& R, int& C) { int st = b / 1024, sb = b % 1024, swz = sb ^ (((sb >> 9) & 1) << 5); R = (st >> 1) * 16 + swz / 64; C = (st & 1) * 32 + (swz % 64) / 2; }

struct EpiBf16 { bf16_t* O; int ldc; int relu2;
    __device__ __forceinline__ void operator()(const f32x4 (&acc)[2][2][4][2], int brow, int bcol, int wr, int wc, int fr, int fq) const {
#pragma unroll
        for (int ai = 0; ai < 2; ++ai)
#pragma unroll
            for (int m = 0; m < 4; ++m) { bf16_t* rp = O + (size_t)(brow + ai * HALF + wr * 64 + m * 16 + fr) * ldc + bcol + wc * 32 + fq * 4;
#pragma unroll
                for (int bj = 0; bj < 2; ++bj)
#pragma unroll
                    for (int n = 0; n < 2; ++n) { f32x4 v = acc[ai][bj][m][n];
                        if (relu2) {
#pragma unroll
                            for (int j = 0; j < 4; ++j) { float t = v[j] > 0.f ? v[j] : 0.f; v[j] = t * t; } }
                        u32x2 w; w.x = cvtpk(v[0], v[1]); w.y = cvtpk(v[2], v[3]); *(u32x2*)(rp + bj * HALF + n * 16) = w; } } } };
struct EpiRes { const float* x0; const float* x1; int split; float* out; int rowoff;
    __device__ __forceinline__ void operator()(const f32x4 (&acc)[2][2][4][2], int brow, int bcol, int wr, int wc, int fr, int fq) const {
#pragma unroll
        for (int ai = 0; ai < 2; ++ai)
#pragma unroll
            for (int m = 0; m < 4; ++m) { const int row = rowoff + brow + ai * HALF + wr * 64 + m * 16 + fr; const int c0 = bcol + wc * 32 + fq * 4;
                const float* xp = (row < split ? x0 + (size_t)row * 1024 : x1 + (size_t)(row - split) * 1024) + c0; float* op = out + (size_t)row * 1024 + c0;
#pragma unroll
                for (int bj = 0; bj < 2; ++bj)
#pragma unroll
                    for (int n = 0; n < 2; ++n) { const f32x4 xv = *(const f32x4*)(xp + bj * HALF + n * 16); *(f32x4*)(op + bj * HALF + n * 16) = xv + acc[ai][bj][m][n]; }
                __builtin_amdgcn_sched_barrier(0); } } };

struct EpiAny { int mode; EpiBf16 eb; EpiRes er;
    __device__ __forceinline__ void operator()(const f32x4 (&acc)[2][2][4][2], int brow, int bcol, int wr, int wc, int fr, int fq) const {
        if (mode == 2) er(acc, brow, bcol, wr, wc, fr, fq); else eb(acc, brow, bcol, wr, wc, fr, fq); } };
struct GemmDesc { const bf16_t* A; const bf16_t* Bt; int lda, ldb, M, N, K; EpiAny epi; };

template <class Epi>
__device__ __forceinline__ void gemm_tile(const Ctx& cx, const char* __restrict__ cA, const char* __restrict__ cB, const size_t hstepA, const size_t hstepB, const unsigned (&voffA)[2], const unsigned (&voffB)[2],
                                          const int nt, const int brow, const int bcol, const Epi& epi) {
    LAS unsigned char* lds = (LAS unsigned char*)smem;
    constexpr int HTB = HT * 2;
    constexpr size_t kstep = BK * 2;
#define SA(b, h) (((b) * 2 + (h)) * HTB)
#define SB(b, h) ((4 + (b) * 2 + (h)) * HTB)
#define STAGE(bufoff, gbase, voff) do { _Pragma("unroll") for (int _i = 0; _i < 2; ++_i) \
      __builtin_amdgcn_global_load_lds((const unsigned*)((const char*)(gbase) + (voff)[_i]), (LAS unsigned*)(lds + (bufoff) + ldsw + _i * 8192), 16, 0, 0); } while (0)
#define LDA(dst, b, h) do { _Pragma("unroll") for (int m = 0; m < 4; ++m) _Pragma("unroll") for (int k = 0; k < 2; ++k) dst[m][k] = *(const LAS bf16x8*)(lds + SA(b, h) + aoff + m * 2048 + k * 1024); } while (0)
#define LDB(dst, b, h) do { _Pragma("unroll") for (int n = 0; n < 2; ++n) _Pragma("unroll") for (int k = 0; k < 2; ++k) dst[n][k] = *(const LAS bf16x8*)(lds + SB(b, h) + boff + n * 2048 + k * 1024); } while (0)
#define MMA(ai, bj, At, Bt_) do { __builtin_amdgcn_s_setprio(1); _Pragma("unroll") for (int m = 0; m < 4; ++m) _Pragma("unroll") for (int n = 0; n < 2; ++n) _Pragma("unroll") for (int k = 0; k < 2; ++k) \
      acc[ai][bj][m][n] = __builtin_amdgcn_mfma_f32_16x16x32_bf16(Bt_[n][k], At[m][k], acc[ai][bj][m][n], 0, 0, 0); \
    __builtin_amdgcn_s_setprio(0); } while (0)
#define WAIT_V(n) asm volatile("s_waitcnt vmcnt(" #n ")" ::: "memory")
#define WAIT_L(n) asm volatile("s_waitcnt lgkmcnt(" #n ")" ::: "memory")
#define BAR __builtin_amdgcn_s_barrier()
#define SCHED __builtin_amdgcn_sched_barrier(0)
    const int wid = __builtin_amdgcn_readfirstlane(cx.tid >> 6), lane = cx.tid & 63, wr = wid >> 2, wc = wid & 3, fr = lane & 15, fq = lane >> 4;
    const unsigned ldsw = (unsigned)wid * 1024u;
    const int aoff = lds_byte(wr * 64 + fr, fq * 8), boff = lds_byte(wc * 32 + fr, fq * 8);
    f32x4 acc[2][2][4][2];
#pragma unroll
    for (int a = 0; a < 2; ++a)
#pragma unroll
        for (int b = 0; b < 2; ++b)
#pragma unroll
            for (int m = 0; m < 4; ++m)
#pragma unroll
                for (int n = 0; n < 2; ++n) acc[a][b][m][n] = (f32x4){0.f, 0.f, 0.f, 0.f};
    bf16x8 At[4][2], B0[2][2], B1[2][2];
    STAGE(SB(0, 0), cB, voffB); STAGE(SA(0, 0), cA, voffA);
    STAGE(SB(0, 1), cB + hstepB, voffB); STAGE(SA(0, 1), cA + hstepA, voffA);
    if (wr == 1) BAR;
    WAIT_V(4); BAR;
    STAGE(SB(1, 0), cB + kstep, voffB); STAGE(SA(1, 0), cA + kstep, voffA); STAGE(SB(1, 1), cB + hstepB + kstep, voffB);
    WAIT_V(6); BAR;
    for (int t = 0; t < nt - 2; t += 2) {
        const char* a1 = cA + (size_t)(t + 1) * kstep; const char* a2 = a1 + kstep; const char* a3 = a2 + kstep;
        const char* b2 = cB + (size_t)(t + 2) * kstep; const char* b3 = b2 + kstep;
        LDB(B0, 0, 0); SCHED; LDA(At, 0, 0); STAGE(SA(1, 1), a1 + hstepA, voffA);
        WAIT_L(8); BAR; WAIT_L(0); MMA(0, 0, At, B0); BAR; SCHED;
        LDB(B1, 0, 1); STAGE(SB(0, 0), b2, voffB);
        BAR; WAIT_L(0); MMA(0, 1, At, B1); BAR;
        LDA(At, 0, 1); STAGE(SA(0, 0), a2, voffA);
        BAR; WAIT_L(0); MMA(1, 0, At, B0); BAR; SCHED;
        STAGE(SB(0, 1), b2 + hstepB, voffB);
        WAIT_V(6); BAR; MMA(1, 1, At, B1); BAR;
        LDB(B0, 1, 0); SCHED; LDA(At, 1, 0); STAGE(SA(0, 1), a2 + hstepA, voffA);
        WAIT_L(8); BAR; WAIT_L(0); MMA(0, 0, At, B0); BAR; SCHED;
        LDB(B1, 1, 1); STAGE(SB(1, 0), b3, voffB);
        BAR; WAIT_L(0); MMA(0, 1, At, B1); BAR;
        LDA(At, 1, 1); STAGE(SA(1, 0), a3, voffA);
        BAR; WAIT_L(0); MMA(1, 0, At, B0); BAR; SCHED;
        STAGE(SB(1, 1), b3 + hstepB, voffB);
        WAIT_V(6); BAR; MMA(1, 1, At, B1); BAR;
    }
    { LDB(B0, 0, 0); LDA(At, 0, 0); STAGE(SA(1, 1), cA + (size_t)(nt - 1) * kstep + hstepA, voffA);
      BAR; WAIT_L(0); MMA(0, 0, At, B0); BAR;
      LDB(B1, 0, 1); BAR; WAIT_L(0); MMA(0, 1, At, B1); BAR;
      LDA(At, 0, 1); WAIT_V(4); BAR; WAIT_L(0); MMA(1, 0, At, B0); MMA(1, 1, At, B1); BAR; }
    { LDB(B0, 1, 0); LDA(At, 1, 0); WAIT_V(2); BAR; WAIT_L(0); MMA(0, 0, At, B0); BAR;
      LDB(B1, 1, 1); WAIT_V(0); BAR; WAIT_L(0); MMA(0, 1, At, B1); BAR;
      LDA(At, 1, 1); BAR; WAIT_L(0); MMA(1, 0, At, B0); MMA(1, 1, At, B1); BAR; }
    if (wr == 0) BAR;
    epi(acc, brow, bcol, wr, wc, fr, fq);
    WAIT_V(0);
#undef SA
#undef SB
#undef STAGE
#undef LDA
#undef LDB
#undef MMA
}

template <class Epi>
__device__ __forceinline__ void gemm_phase(const Ctx& cx, const bf16_t* A, int lda, const bf16_t* Bt, int ldb, int M, int N, int K, const Epi& epi) {
    const int nM = M / BM, nN = N / BM, b = cx.bid, per = (nM >> 3) * nN, step = cx.nb >> 3;
    unsigned voffA[2], voffB[2];
#pragma unroll
    for (int i = 0; i < 2; ++i) { int R, C; stage_rc(cx.tid * 16 + i * 8192, R, C); voffA[i] = (unsigned)(R * lda + C) * 2u; voffB[i] = (unsigned)(R * ldb + C) * 2u; }
    const size_t hstepA = (size_t)HALF * lda * 2, hstepB = (size_t)HALF * ldb * 2;
    for (int w = b >> 3; w < per; w += step) {
        const int pm = (b & 7) + 8 * (w / nN), pn = w % nN;
        gemm_tile(cx, (const char*)A + (size_t)pm * 2 * hstepA, (const char*)Bt + (size_t)pn * 2 * hstepB, hstepA, hstepB, voffA, voffB, K / BK, pm * BM, pn * BM, epi);
    }
}
}

__device__ __forceinline__ void norm_rows(const Ctx& cx, const float* src0, const float* src1, int split, const float* __restrict__ g, bf16_t* dst, int nrows) {
    const int lane = cx.tid & 63, gw = cx.bid * 8 + (cx.tid >> 6), nw = cx.nb * 8;
    f32x4 gv[4];
#pragma unroll
    for (int i = 0; i < 4; ++i) gv[i] = *(const f32x4*)(g + i * 256 + lane * 4);
    for (int row = gw; row < nrows; row += nw) {
        const float* s = row < split ? src0 + (size_t)row * 1024 : src1 + (size_t)(row - split) * 1024;
        f32x4 v[4]; float ss = 0.f;
#pragma unroll
        for (int i = 0; i < 4; ++i) { v[i] = *(const f32x4*)(s + i * 256 + lane * 4); ss += v[i][0] * v[i][0] + v[i][1] * v[i][1] + v[i][2] * v[i][2] + v[i][3] * v[i][3]; }
        ss = wave_sum(ss, lane);
        const float rs = rsqrtf(ss * (1.0f / 1024.0f) + EPS);
#pragma unroll
        for (int i = 0; i < 4; ++i) { u32x2 w; w.x = cvtpk(v[i][0] * rs * gv[i][0], v[i][1] * rs * gv[i][1]); w.y = cvtpk(v[i][2] * rs * gv[i][2], v[i][3] * rs * gv[i][3]);
            *(u32x2*)(dst + (size_t)row * 1024 + i * 256 + lane * 4) = w; }
    }
}

template <class F>
__device__ __forceinline__ void wconv(const Ctx& cx, bf16_t* dst, int Np, int Kp, F src) {
    const int gt = cx.bid * 512 + cx.tid, nt = cx.nb * 512;
    const int total = Np * (Kp >> 3);
    for (int idx = gt; idx < total; idx += nt) {
        const int n = idx % Np, k0 = (idx / Np) << 3; float f[8];
#pragma unroll
        for (int i = 0; i < 8; ++i) f[i] = src(n, k0 + i);
        *(u32x4*)(dst + (size_t)n * Kp + k0) = pack8(f);
    }
}

__device__ __forceinline__ void prologue(const Ctx& cx, PP p) {
    bf16_t* W = (bf16_t*)(p->ws + OFF_W);
    for (int l = 0; l < 2; ++l) {
        bf16_t* Wl = W + (size_t)l * W_LAYER_E;
        { const float* s = p->in[5] + (size_t)l * 1024 * 1952; wconv(cx, Wl + WO_IN, 2048, 1024, [=](int n, int k) -> float { return n < 1952 ? s[(size_t)k * 1952 + n] : 0.f; }); }
        { const float* uq = p->in[10] + (size_t)l * 256 * 768; const float* ukv = p->in[11] + (size_t)l * 128 * 1024;
          wconv(cx, Wl + WO_QKV, 2048, 384, [=](int n, int k) -> float { const int h = n >> 8, j = n & 255;
              if (j < 96) return k < 256 ? uq[(size_t)k * 768 + h * 96 + j] : 0.f;
              if (j < 160) return k >= 256 ? ukv[(size_t)(k - 256) * 1024 + h * 128 + (j - 96)] : 0.f;
              if (j < 192) return 0.f;
              return k >= 256 ? ukv[(size_t)(k - 256) * 1024 + h * 128 + 64 + (j - 192)] : 0.f; }); }
        { const float* s = p->in[16] + (size_t)l * 1024 * 1024; wconv(cx, Wl + WO_OUT, 1024, 1024, [=](int n, int k) -> float { return s[(size_t)k * 1024 + n]; }); }
        { const float* s = p->in[19] + (size_t)l * 1024 * 512; wconv(cx, Wl + WO_MQ, 512, 1024, [=](int n, int k) -> float { return s[(size_t)k * 512 + n]; }); }
        { const float* s = p->in[20] + (size_t)l * 1024 * 1024; wconv(cx, Wl + WO_MKV, 1024, 1024, [=](int n, int k) -> float { return s[(size_t)k * 1024 + n]; }); }
        { const float* s = p->in[23] + (size_t)l * 512 * 1024; wconv(cx, Wl + WO_MO, 1024, 512, [=](int n, int k) -> float { return s[(size_t)k * 1024 + n]; }); }
        { const float* s = p->in[25] + (size_t)l * 1024 * 4096; wconv(cx, Wl + WO_1, 4096, 1024, [=](int n, int k) -> float { return s[(size_t)k * 4096 + n]; }); }
        { const float* s = p->in[26] + (size_t)l * 4096 * 1024; wconv(cx, Wl + WO_2, 1024, 4096, [=](int n, int k) -> float { return s[(size_t)k * 1024 + n]; }); }
    }
    float2* cs = (float2*)(p->ws + OFF_CS);
    const int gt = cx.bid * 512 + cx.tid, nt = cx.nb * 512;
    for (int idx = gt; idx < 8192 * 16; idx += nt) { const int pos = idx >> 4, j = idx & 15;
        double inv = 1.0; for (int k = 0; k < j; ++k) inv *= 0.44036660267178046;
        double tt = (double)pos * inv * 0.15915494309189535; tt -= floor(tt);
        const float fr = (float)tt; cs[idx] = make_float2(__builtin_amdgcn_cosf(fr), __builtin_amdgcn_sinf(fr)); }
}

__device__ __forceinline__ void prep_a(const Ctx& cx, PP p, int l) {
    bf16_t* PROJ = (bf16_t*)(p->ws + OFF_RA); bf16_t* KVM = (bf16_t*)(p->ws + OFF_KVM); const float2* cs = (const float2*)(p->ws + OFF_CS);
    const int lane = cx.tid & 63, gw = cx.bid * 8 + (cx.tid >> 6), nw = cx.nb * 8;
    const int seg = lane & 7;
    float gq[8], gk[8], gcq[4], gckv[2], gkm[8];
#pragma unroll
    for (int i = 0; i < 8; ++i) { gq[i] = p->in[6][l * 64 + seg * 8 + i]; gk[i] = p->in[7][l * 64 + seg * 8 + i]; gkm[i] = p->in[22][l * 128 + (lane & 15) * 8 + i]; }
#pragma unroll
    for (int i = 0; i < 4; ++i) gcq[i] = p->in[8][l * 256 + lane * 4 + i];
    gckv[0] = p->in[9][l * 128 + lane * 2]; gckv[1] = p->in[9][l * 128 + lane * 2 + 1];
    const float qscale = 0.125f * LOG2E;
    for (int tok = gw; tok < T; tok += nw) {
        int seqbase, S; seq_of_tok(tok, seqbase, S); const int pos = tok - seqbase;
        bf16_t* R = PROJ + (size_t)tok * LDP;
        float2 c = make_float2(1.f, 0.f);
        float cc[8], sn[8];
#pragma unroll
        for (int i = 0; i < 8; ++i) { const float2 t = cs[pos * 16 + 2 * i]; cc[i] = t.x; sn[i] = t.y; }
        (void)c;
#pragma unroll
        for (int which = 0; which < 2; ++which) {
            bf16_t* ptr = R + which * 512 + lane * 8; float f[8]; unpack8(*(const u32x4*)ptr, f);
            float ss = 0.f;
#pragma unroll
            for (int i = 0; i < 8; ++i) ss += f[i] * f[i];
            ss += shx(ss, 1, lane); ss += shx(ss, 2, lane); ss += shx(ss, 4, lane);
            const float rs = rsqrtf(ss * (1.0f / 64.0f) + EPS);
#pragma unroll
            for (int i = 0; i < 8; ++i) f[i] = f[i] * rs * (which == 0 ? gq[i] : gk[i]);
            float o[8];
#pragma unroll
            for (int i = 0; i < 8; ++i) { const float pr = shx(f[i], 1, lane);
                o[i] = seg == 0 ? f[i] * cc[i] - pr * sn[i] : (seg == 1 ? f[i] * cc[i] + pr * sn[i] : f[i]); }
            if (which == 0) {
#pragma unroll
                for (int i = 0; i < 8; ++i) o[i] *= qscale; }
            *(u32x4*)ptr = pack8(o);
        }
        { bf16_t* ptr = R + 1536 + lane * 4; const u32x2 v = *(const u32x2*)ptr; float f[4] = {bflo(v.x), bfhi(v.x), bflo(v.y), bfhi(v.y)};
          float ss = wave_sum(f[0] * f[0] + f[1] * f[1] + f[2] * f[2] + f[3] * f[3], lane); const float rs = rsqrtf(ss * (1.0f / 256.0f) + EPS);
          u32x2 w; w.x = cvtpk(f[0] * rs * gcq[0], f[1] * rs * gcq[1]); w.y = cvtpk(f[2] * rs * gcq[2], f[3] * rs * gcq[3]); *(u32x2*)ptr = w; }
        { bf16_t* ptr = R + 1792 + lane * 2; const unsigned v = *(const unsigned*)ptr; float f0 = bflo(v), f1 = bfhi(v);
          float ss = wave_sum(f0 * f0 + f1 * f1, lane); const float rs = rsqrtf(ss * (1.0f / 128.0f) + EPS);
          *(unsigned*)ptr = cvtpk(f0 * rs * gckv[0], f1 * rs * gckv[1]); }
    }
    for (int row = gw; row < NMEMTOK; row += nw) {
        bf16_t* ptr = KVM + (size_t)row * 1024 + lane * 8; float f[8]; unpack8(*(const u32x4*)ptr, f);
        float ss = 0.f;
#pragma unroll
        for (int i = 0; i < 8; ++i) ss += f[i] * f[i];
        ss += shx(ss, 1, lane); ss += shx(ss, 2, lane); ss += shx(ss, 4, lane); ss += shx(ss, 8, lane);
        const float rs = rsqrtf(ss * (1.0f / 128.0f) + EPS);
#pragma unroll
        for (int i = 0; i < 8; ++i) f[i] = f[i] * rs * gkm[i];
        *(u32x4*)ptr = pack8(f);
    }
}

__device__ __forceinline__ void prep_b(const Ctx& cx, PP p, int l) {
    const bf16_t* PROJ = (const bf16_t*)(p->ws + OFF_RA); bf16_t* QKVB = (bf16_t*)(p->ws + OFF_RB); const float2* cs = (const float2*)(p->ws + OFF_CS);
    const int lane = cx.tid & 63, gw = cx.bid * 8 + (cx.tid >> 6), nw = cx.nb * 8;
    const bool active = lane < 48; const int h = active ? lane / 6 : 0, seg = active ? lane % 6 : 0;
    float gq[16], gk[16];
#pragma unroll
    for (int i = 0; i < 16; ++i) { gq[i] = p->in[12][l * 96 + seg * 16 + i]; gk[i] = p->in[13][l * 96 + seg * 16 + i]; }
    const float qscale = 0.10206207261596577f * LOG2E;
    const int partner = seg == 4 ? lane + 1 : (seg == 5 ? lane - 1 : lane);
    for (int tok = gw; tok < T; tok += nw) {
        int seqbase, S; seq_of_tok(tok, seqbase, S); const int pos = tok - seqbase;
        bf16_t* R = QKVB + (size_t)tok * LDP + h * 256;
#pragma unroll
        for (int which = 0; which < 2; ++which) {
            const bf16_t* src = which == 0 ? R + seg * 16 : (seg < 4 ? R + 96 + seg * 16 : PROJ + (size_t)tok * LDP + 1920 + (seg - 4) * 16);
            bf16_t* dst = R + which * 96 + seg * 16;
            float f[16]; unpack8(*(const u32x4*)src, f); unpack8(*(const u32x4*)(src + 8), f + 8);
            float ss = 0.f;
#pragma unroll
            for (int i = 0; i < 16; ++i) ss += f[i] * f[i];
            float tot = 0.f;
#pragma unroll
            for (int s2 = 0; s2 < 6; ++s2) tot += shl(ss, h * 6 + s2);
            const float rs = rsqrtf(tot * (1.0f / 96.0f) + EPS);
#pragma unroll
            for (int i = 0; i < 16; ++i) f[i] = f[i] * rs * (which == 0 ? gq[i] : gk[i]);
            float o[16];
#pragma unroll
            for (int i = 0; i < 16; ++i) { const float pr = shl(f[i], partner); const float2 t = cs[pos * 16 + i];
                o[i] = seg == 4 ? f[i] * t.x - pr * t.y : (seg == 5 ? f[i] * t.x + pr * t.y : f[i]); }
            if (which == 0) {
#pragma unroll
                for (int i = 0; i < 16; ++i) o[i] *= qscale; }
            if (active) { *(u32x4*)dst = pack8(o); *(u32x4*)(dst + 8) = pack8(o + 8); }
        }
    }
}

__device__ __forceinline__ void out_norm(const Ctx& cx, PP p, int l) {
    bf16_t* PROJ = (bf16_t*)(p->ws + OFF_RA);
    const int lane = cx.tid & 63, gw = cx.bid * 8 + (cx.tid >> 6), nw = cx.nb * 8;
    float ga[8], gb[8];
#pragma unroll
    for (int i = 0; i < 8; ++i) { ga[i] = p->in[14][l * 512 + lane * 8 + i]; gb[i] = p->in[15][l * 512 + lane * 8 + i]; }
    for (int tok = gw; tok < T; tok += nw) {
        bf16_t* R = PROJ + (size_t)tok * LDP; float a[8], b[8];
        unpack8(*(const u32x4*)(R + lane * 8), a); unpack8(*(const u32x4*)(R + 1536 + lane * 8), b);
        float sa = 0.f, sb = 0.f;
#pragma unroll
        for (int i = 0; i < 8; ++i) { sa += a[i] * a[i]; sb += b[i] * b[i]; }
        sa = wave_sum(sa, lane); sb = wave_sum(sb, lane);
        const float ra = rsqrtf(sa * (1.0f / 512.0f) + EPS), rb = rsqrtf(sb * (1.0f / 512.0f) + EPS);
#pragma unroll
        for (int i = 0; i < 8; ++i) { a[i] = a[i] * ra * ga[i]; b[i] = b[i] * rb * gb[i]; }
        *(u32x4*)(R + lane * 8) = pack8(a); *(u32x4*)(R + 512 + lane * 8) = pack8(b);
    }
}

#define MFMA16(a, b, c) __builtin_amdgcn_mfma_f32_16x16x32_bf16(a, b, c, 0, 0, 0)
__device__ __forceinline__ s16x4 vtr(const LAS unsigned char* p) { return __builtin_bit_cast(s16x4, __builtin_amdgcn_ds_read_tr16_b64_v4i16((LAS v4i16_t*)p)); }

template <int DQK, int DV, int KT, int QG, bool QNORM>
__device__ __forceinline__ void attn_dense(const Ctx& cx, const bf16_t* Q, int ldq, const bf16_t* Kb, int ldk, const bf16_t* Vb, int ldv, int nkeys,
                                           bf16_t* O, int ldo, const float* qgain, float qscale) {
    constexpr int KC = DQK / 32, DVT = DV / 16, KSTR = DQK * 2 + 16, VSTR = (DV == 64) ? 160 : 288;
    constexpr int KBUF = KT * KSTR, VBUF = KT * VSTR, STG = KBUF + VBUF;
    constexpr int KCPR = DQK / 8, VCPR = DV / 8, KPER = KT * KCPR / 512, VPER = KT * VCPR / 512;
    static_assert(2 * STG <= LDS_BYTES, "LDS");
    const int tid = cx.tid, wid = tid >> 6, lane = tid & 63, fr = lane & 15, fq = lane >> 4;
    LAS unsigned char* lds = (LAS unsigned char*)smem;
    bf16x8 qf[QG][KC];
#pragma unroll
    for (int qg = 0; qg < QG; ++qg) {
        const bf16_t* qp = Q + (size_t)(wid * 16 * QG + qg * 16 + fr) * ldq;
        if (QNORM) {
            float f[KC][8]; float ss = 0.f;
#pragma unroll
            for (int kc = 0; kc < KC; ++kc) { unpack8(*(const u32x4*)(qp + kc * 32 + fq * 8), f[kc]);
#pragma unroll
                for (int i = 0; i < 8; ++i) ss += f[kc][i] * f[kc][i]; }
            ss += shx(ss, 16, lane); ss += shx(ss, 32, lane);
            const float rs = rsqrtf(ss * (1.0f / DQK) + EPS) * qscale;
#pragma unroll
            for (int kc = 0; kc < KC; ++kc) {
#pragma unroll
                for (int i = 0; i < 8; ++i) f[kc][i] = f[kc][i] * rs * qgain[kc * 32 + fq * 8 + i];
                qf[qg][kc] = __builtin_bit_cast(bf16x8, pack8(f[kc])); }
        } else {
#pragma unroll
            for (int kc = 0; kc < KC; ++kc) qf[qg][kc] = *(const bf16x8*)(qp + kc * 32 + fq * 8);
        }
    }
    float mrun[QG], lrun[QG]; f32x4 o[QG][DVT];
#pragma unroll
    for (int qg = 0; qg < QG; ++qg) { mrun[qg] = -1e30f; lrun[qg] = 0.f;
#pragma unroll
        for (int d = 0; d < DVT; ++d) o[qg][d] = (f32x4){0.f, 0.f, 0.f, 0.f}; }
    u32x4 kreg[KPER], vreg[VPER];
    const int ntiles = nkeys / KT;
#pragma unroll
    for (int i = 0; i < KPER; ++i) { const int c = tid + i * 512, row = c / KCPR, cc = c % KCPR; kreg[i] = *(const u32x4*)(Kb + (size_t)row * ldk + cc * 8); }
#pragma unroll
    for (int i = 0; i < VPER; ++i) { const int c = tid + i * 512, row = c / VCPR, cc = c % VCPR; vreg[i] = *(const u32x4*)(Vb + (size_t)row * ldv + cc * 8); }
#pragma unroll
    for (int i = 0; i < KPER; ++i) { const int c = tid + i * 512, row = c / KCPR, cc = c % KCPR; *(LAS u32x4*)(lds + row * KSTR + cc * 16) = kreg[i]; }
#pragma unroll
    for (int i = 0; i < VPER; ++i) { const int c = tid + i * 512, row = c / VCPR, cc = c % VCPR; *(LAS u32x4*)(lds + KBUF + row * VSTR + cc * 16) = vreg[i]; }
    __syncthreads();
    for (int t = 0; t < ntiles; ++t) {
        const bool more = t + 1 < ntiles;
        if (more) {
            const int k0 = (t + 1) * KT;
#pragma unroll
            for (int i = 0; i < KPER; ++i) { const int c = tid + i * 512, row = c / KCPR, cc = c % KCPR; kreg[i] = *(const u32x4*)(Kb + (size_t)(k0 + row) * ldk + cc * 8); }
#pragma unroll
            for (int i = 0; i < VPER; ++i) { const int c = tid + i * 512, row = c / VCPR, cc = c % VCPR; vreg[i] = *(const u32x4*)(Vb + (size_t)(k0 + row) * ldv + cc * 8); }
        }
        const LAS unsigned char* Kl = lds + (t & 1) * STG; const LAS unsigned char* Vl = Kl + KBUF;
#pragma unroll
        for (int sub = 0; sub < KT / 64; ++sub) {
            f32x4 s[QG][4];
#pragma unroll
            for (int qg = 0; qg < QG; ++qg)
#pragma unroll
                for (int kt = 0; kt < 4; ++kt) s[qg][kt] = (f32x4){0.f, 0.f, 0.f, 0.f};
#pragma unroll
            for (int kt = 0; kt < 4; ++kt)
#pragma unroll
                for (int kc = 0; kc < KC; ++kc) { const bf16x8 a = *(const LAS bf16x8*)(Kl + (sub * 64 + kt * 16 + fr) * KSTR + (kc * 32 + fq * 8) * 2);
#pragma unroll
                    for (int qg = 0; qg < QG; ++qg) s[qg][kt] = MFMA16(a, qf[qg][kc], s[qg][kt]); }
            bf16x8 pb[QG][2];
#pragma unroll
            for (int qg = 0; qg < QG; ++qg) {
                float mx = s[qg][0][0];
#pragma unroll
                for (int kt = 0; kt < 4; ++kt)
#pragma unroll
                    for (int j = 0; j < 4; ++j) mx = fmaxf(mx, s[qg][kt][j]);
                mx = fmaxf(mx, shx(mx, 16, lane)); mx = fmaxf(mx, shx(mx, 32, lane));
                const float mn = fmaxf(mrun[qg], mx), alpha = __builtin_amdgcn_exp2f(mrun[qg] - mn); mrun[qg] = mn;
                float rsum = 0.f;
#pragma unroll
                for (int kt = 0; kt < 4; ++kt)
#pragma unroll
                    for (int j = 0; j < 4; ++j) { const float pv = __builtin_amdgcn_exp2f(s[qg][kt][j] - mn); s[qg][kt][j] = pv; rsum += pv; }
                lrun[qg] = lrun[qg] * alpha + rsum;
#pragma unroll
                for (int d = 0; d < DVT; ++d) o[qg][d] = o[qg][d] * alpha;
#pragma unroll
                for (int t2 = 0; t2 < 2; ++t2) { u32x4 w; w.x = cvtpk(s[qg][2 * t2][0], s[qg][2 * t2][1]); w.y = cvtpk(s[qg][2 * t2][2], s[qg][2 * t2][3]);
                    w.z = cvtpk(s[qg][2 * t2 + 1][0], s[qg][2 * t2 + 1][1]); w.w = cvtpk(s[qg][2 * t2 + 1][2], s[qg][2 * t2 + 1][3]); pb[qg][t2] = __builtin_bit_cast(bf16x8, w); }
            }
#pragma unroll
            for (int t2 = 0; t2 < 2; ++t2)
#pragma unroll
                for (int d = 0; d < DVT; ++d) {
                    const LAS unsigned char* vp = Vl + (sub * 64 + t2 * 32 + fq * 4 + (fr >> 2)) * VSTR + (d * 16 + 4 * (fr & 3)) * 2;
                    const s16x4 lo = vtr(vp), hi = vtr(vp + 16 * VSTR);
                    const bf16x8 a = __builtin_shufflevector(lo, hi, 0, 1, 2, 3, 4, 5, 6, 7);
#pragma unroll
                    for (int qg = 0; qg < QG; ++qg) o[qg][d] = MFMA16(a, pb[qg][t2], o[qg][d]);
                }
        }
        if (more) {
            LAS unsigned char* Kn = lds + ((t + 1) & 1) * STG;
#pragma unroll
            for (int i = 0; i < KPER; ++i) { const int c = tid + i * 512, row = c / KCPR, cc = c % KCPR; *(LAS u32x4*)(Kn + row * KSTR + cc * 16) = kreg[i]; }
#pragma unroll
            for (int i = 0; i < VPER; ++i) { const int c = tid + i * 512, row = c / VCPR, cc = c % VCPR; *(LAS u32x4*)(Kn + KBUF + row * VSTR + cc * 16) = vreg[i]; }
        }
        __syncthreads();
    }
#pragma unroll
    for (int qg = 0; qg < QG; ++qg) {
        float lt = lrun[qg]; lt += shx(lt, 16, lane); lt += shx(lt, 32, lane);
        const float inv = 1.0f / lt;
        bf16_t* op = O + (size_t)(wid * 16 * QG + qg * 16 + fr) * ldo + fq * 4;
#pragma unroll
        for (int d = 0; d < DVT; ++d) { u32x2 w; w.x = cvtpk(o[qg][d][0] * inv, o[qg][d][1] * inv); w.y = cvtpk(o[qg][d][2] * inv, o[qg][d][3] * inv); *(u32x2*)(op + d * 16) = w; }
    }
}

__device__ __forceinline__ void attn_win_item(const Ctx& cx, bf16_t* PROJ, int seqbase, int S, int P0, int r, int head, LAS unsigned char* vl) {
    const int lane = cx.tid & 63, fr = lane & 15, fq = lane >> 4;
    const int pq = P0 + r + 16 * fr;
    bf16_t* qrow = PROJ + (size_t)(seqbase + pq) * LDP + head * 64;
    bf16x8 qf[2];
    qf[0] = *(const bf16x8*)(qrow + fq * 8); qf[1] = *(const bf16x8*)(qrow + 32 + fq * 8);
    float mrun = -1e30f, lrun = 0.f; f32x4 o[4];
#pragma unroll
    for (int d = 0; d < 4; ++d) o[d] = (f32x4){0.f, 0.f, 0.f, 0.f};
    const bf16_t* Kbase = PROJ + (size_t)seqbase * LDP + 512 + head * 64;
    const bf16_t* Vbase = PROJ + (size_t)seqbase * LDP + 1024 + head * 64;
    for (int st = 0; st < 23; ++st) {
        int d, ls; if (st < 5) { d = 16; ls = st; } else if (st < 11) { d = 4; ls = st - 5; } else { d = 1; ls = st - 11; }
        const int W = 64 * d, kb = P0 + r - W + d * (ls * 32);
        bf16x8 kf[2][2];
#pragma unroll
        for (int kt = 0; kt < 2; ++kt) { int pk = kb + d * (kt * 16 + fr); pk = pk < 0 ? 0 : (pk > S - 1 ? S - 1 : pk);
            const bf16_t* kp = Kbase + (size_t)pk * LDP; kf[kt][0] = *(const bf16x8*)(kp + fq * 8); kf[kt][1] = *(const bf16x8*)(kp + 32 + fq * 8); }
        u32x4 vv[4];
#pragma unroll
        for (int c = 0; c < 4; ++c) { int pk = kb + d * (c * 8 + (lane >> 3)); pk = pk < 0 ? 0 : (pk > S - 1 ? S - 1 : pk);
            vv[c] = *(const u32x4*)(Vbase + (size_t)pk * LDP + (lane & 7) * 8); }
#pragma unroll
        for (int c = 0; c < 4; ++c) *(LAS u32x4*)(vl + (c * 8 + (lane >> 3)) * 160 + (lane & 7) * 16) = vv[c];
        f32x4 s[2];
#pragma unroll
        for (int kt = 0; kt < 2; ++kt) { s[kt] = (f32x4){0.f, 0.f, 0.f, 0.f}; s[kt] = MFMA16(kf[kt][0], qf[0], s[kt]); s[kt] = MFMA16(kf[kt][1], qf[1], s[kt]); }
        bool valid[2][4]; float mx = -1e30f;
#pragma unroll
        for (int kt = 0; kt < 2; ++kt)
#pragma unroll
            for (int j = 0; j < 4; ++j) { const int pk = kb + d * (kt * 16 + fq * 4 + j); const int dl = pk - pq;
                valid[kt][j] = (pk >= 0) && (pk < S) && (dl <= W) && (dl >= -W); if (valid[kt][j]) mx = fmaxf(mx, s[kt][j]); }
        mx = fmaxf(mx, shx(mx, 16, lane)); mx = fmaxf(mx, shx(mx, 32, lane));
        const float mn = fmaxf(mrun, mx), alpha = __builtin_amdgcn_exp2f(mrun - mn); mrun = mn;
        float rsum = 0.f;
#pragma unroll
        for (int kt = 0; kt < 2; ++kt)
#pragma unroll
            for (int j = 0; j < 4; ++j) { const float pv = valid[kt][j] ? __builtin_amdgcn_exp2f(s[kt][j] - mn) : 0.f; s[kt][j] = pv; rsum += pv; }
        lrun = lrun * alpha + rsum;
        u32x4 w; w.x = cvtpk(s[0][0], s[0][1]); w.y = cvtpk(s[0][2], s[0][3]); w.z = cvtpk(s[1][0], s[1][1]); w.w = cvtpk(s[1][2], s[1][3]);
        const bf16x8 pb = __builtin_bit_cast(bf16x8, w);
#pragma unroll
        for (int dv = 0; dv < 4; ++dv) {
            const LAS unsigned char* vp = vl + (fq * 4 + (fr >> 2)) * 160 + (dv * 16 + 4 * (fr & 3)) * 2;
            const s16x4 lo = vtr(vp), hi = vtr(vp + 16 * 160);
            const bf16x8 a = __builtin_shufflevector(lo, hi, 0, 1, 2, 3, 4, 5, 6, 7);
            o[dv] = o[dv] * alpha; o[dv] = MFMA16(a, pb, o[dv]);
        }
    }
    float lt = lrun; lt += shx(lt, 16, lane); lt += shx(lt, 32, lane);
    const float inv = 1.0f / lt;
#pragma unroll
    for (int dv = 0; dv < 4; ++dv) { u32x2 w; w.x = cvtpk(o[dv][0] * inv, o[dv][1] * inv); w.y = cvtpk(o[dv][2] * inv, o[dv][3] * inv); *(u32x2*)(qrow + dv * 16 + fq * 4) = w; }
}

__device__ __forceinline__ void attn_ab(const Ctx& cx, PP p) {
    bf16_t* PROJ = (bf16_t*)(p->ws + OFF_RA); bf16_t* QKVB = (bf16_t*)(p->ws + OFF_RB);
    const int b = cx.bid, G = cx.nb;
    for (int u = b; u < 1536; u += G) {
        int seq, head, qb;
        if (u < 1024) { const int i = u >> 8, bb = u & 255; seq = 4 + i; head = bb & 7; qb = bb >> 3; }
        else { const int v = u - 1024, i = v >> 8, bb = v & 255; head = bb & 7; seq = 2 * i + ((bb >> 3) >> 4); qb = (bb >> 3) & 15; }
        const int seqbase = seq < 4 ? seq * 4096 : TP + (seq - 4) * 8192, S = seq < 4 ? 4096 : 8192;
        const int tok0 = seqbase + qb * 256;
        attn_dense<96, 64, 128, 2, false>(cx, QKVB + (size_t)tok0 * LDP + head * 256, LDP, QKVB + (size_t)seqbase * LDP + head * 256 + 96, LDP,
                                          QKVB + (size_t)seqbase * LDP + head * 256 + 192, LDP, S, PROJ + (size_t)tok0 * LDP + 1536 + head * 64, LDP, nullptr, 1.f);
    }
    const int wid = cx.tid >> 6;
    LAS unsigned char* vl = (LAS unsigned char*)smem + wid * 5120;
    for (int g = b * 8 + wid; g < (T / 16) * 8; g += G * 8) {
        const int r = g & 15, head = (g >> 4) & 7, blk = g >> 7; const int tok0 = blk * 256;
        int seqbase, S; seq_of_tok(tok0, seqbase, S);
        attn_win_item(cx, PROJ, seqbase, S, tok0 - seqbase, r, head, vl);
    }
}

__device__ __forceinline__ void attn_mem(const Ctx& cx, PP p, int l) {
    bf16_t* QM = (bf16_t*)(p->ws + OFF_RA); const bf16_t* KVM = (const bf16_t*)(p->ws + OFF_KVM);
    const int b = cx.bid, G = cx.nb;
    for (int u = b; u < (T / 256) * 4; u += G) {
        const int head = u & 3, blk = u >> 2, tok0 = blk * 256;
        const int seq = tok0 < TP ? tok0 >> 12 : 4 + ((tok0 - TP) >> 13);
        const int mrow0 = seq * 256;
        attn_dense<128, 128, 64, 2, true>(cx, QM + (size_t)tok0 * 512 + head * 128, 512, KVM + (size_t)mrow0 * 1024 + head * 128, 1024,
                                          KVM + (size_t)mrow0 * 1024 + 512 + head * 128, 1024, 256, QM + (size_t)tok0 * 512 + head * 128, 512,
                                          p->in[21] + l * 128, 0.08838834764831845f * LOG2E);
    }
}

__device__ __forceinline__ g8::GemmDesc mk_bf16(const bf16_t* A, int lda, const bf16_t* Bt, int ldb, int M, int N, int K, bf16_t* O, int ldc, int relu2) {
    g8::GemmDesc d; d.A = A; d.Bt = Bt; d.lda = lda; d.ldb = ldb; d.M = M; d.N = N; d.K = K; d.epi.mode = relu2; d.epi.eb = g8::EpiBf16{O, ldc, relu2}; d.epi.er = g8::EpiRes{nullptr, nullptr, 0, nullptr, 0}; return d; }
__device__ __forceinline__ g8::GemmDesc mk_res(const bf16_t* A, int lda, const bf16_t* Bt, int ldb, int M, int N, int K, const float* x0, const float* x1, int split, float* out, int rowoff) {
    g8::GemmDesc d; d.A = A; d.Bt = Bt; d.lda = lda; d.ldb = ldb; d.M = M; d.N = N; d.K = K; d.epi.mode = 2; d.epi.eb = g8::EpiBf16{nullptr, 0, 0}; d.epi.er = g8::EpiRes{x0, x1, split, out, rowoff}; return d; }

__device__ __forceinline__ void run_phase(const Ctx& cx, PP p, int ph) {
    const int l = ph / NPH_LAYER, q = ph % NPH_LAYER;
    bf16_t* W = (bf16_t*)(p->ws + OFF_W) + (size_t)l * W_LAYER_E;
    bf16_t* RA = (bf16_t*)(p->ws + OFF_RA); bf16_t* RB = (bf16_t*)(p->ws + OFF_RB);
    bf16_t* MM = (bf16_t*)(p->ws + OFF_MM); bf16_t* KVM = (bf16_t*)(p->ws + OFF_KVM);
    const float* x0 = l == 0 ? p->in[0] : p->out; const float* x1 = l == 0 ? p->in[1] : p->out + (size_t)TP * 1024;
    int ng = 0; g8::GemmDesc d0 = mk_bf16(nullptr, 0, nullptr, 0, 0, 0, 0, nullptr, 0, 0), d1 = d0;
    switch (q) {
    case 0:
        if (l == 0) prologue(cx, p);
        norm_rows(cx, x0, x1, TP, p->in[4] + l * 1024, RB, T);
        norm_rows(cx, p->in[2], p->in[3], 1024, p->in[18] + l * 1024, MM, NMEMTOK);
        break;
    case 1: ng = 2; d0 = mk_bf16(RB, 1024, W + WO_IN, 1024, T, 2048, 1024, RA, LDP, 0); d1 = mk_bf16(MM, 1024, W + WO_MKV, 1024, NMEMTOK, 1024, 1024, KVM, 1024, 0); break;
    case 2: prep_a(cx, p, l); break;
    case 3: ng = 1; d0 = mk_bf16(RA + 1536, LDP, W + WO_QKV, 384, T, 2048, 384, RB, LDP, 0); break;
    case 4: prep_b(cx, p, l); break;
    case 5: attn_ab(cx, p); break;
    case 6: out_norm(cx, p, l); break;
    case 7: ng = 1; d0 = mk_res(RA, LDP, W + WO_OUT, 1024, T, 1024, 1024, x0, x1, TP, p->out, 0); break;
    case 8: norm_rows(cx, p->out, p->out, T, p->in[17] + l * 1024, RB, T); break;
    case 9: ng = 1; d0 = mk_bf16(RB, 1024, W + WO_MQ, 1024, T, 512, 1024, RA, 512, 0); break;
    case 10: attn_mem(cx, p, l); break;
    case 11: ng = 1; d0 = mk_res(RA, 512, W + WO_MO, 512, T, 1024, 512, p->out, p->out, T, p->out, 0); break;
    case 12: norm_rows(cx, p->out, p->out, T, p->in[24] + l * 1024, RB, T); break;
    default: {
        const int c = (q - 13) >> 1, rowoff = c * 16384; ng = 1;
        if (((q - 13) & 1) == 0) d0 = mk_bf16(RB + (size_t)rowoff * 1024, 1024, W + WO_1, 1024, 16384, 4096, 1024, RA, 4096, 1);
        else d0 = mk_res(RA, 4096, W + WO_2, 4096, 16384, 1024, 4096, p->out, p->out, T, p->out, rowoff);
    } break;
    }
#pragma unroll 1
    for (int gi = 0; gi < ng; ++gi) { const g8::GemmDesc d = gi == 0 ? d0 : d1; g8::gemm_phase(cx, d.A, d.lda, d.Bt, d.ldb, d.M, d.N, d.K, d.epi); }
}

__global__ void __launch_bounds__(512) mega_fwd(Params pv) {
    cg::grid_group grid = cg::this_grid();
    const int ph_lo = pv.ph_lo, ph_hi = pv.ph_hi;
    int wid_s = __builtin_amdgcn_readfirstlane(threadIdx.x >> 6);
    for (int ph = ph_lo; ph < ph_hi; ++ph) {
        Ctx cx; cx.bid = blockIdx.x; cx.nb = gridDim.x;
        asm volatile("" : "+s"(wid_s));
        int lane_; asm volatile("v_mbcnt_lo_u32_b32 %0, -1, 0\n\tv_mbcnt_hi_u32_b32 %0, -1, %0" : "=v"(lane_));
        cx.tid = wid_s * 64 + lane_;
        asm volatile("" : "+s"(cx.bid)); asm volatile("" : "+s"(cx.nb));
        auto ka = __builtin_amdgcn_kernarg_segment_ptr();
        asm volatile("" : "+s"(ka));
        run_phase(cx, (PP)ka, ph);
        if (ph + 1 < ph_hi) grid.sync();
    }
}

extern "C" void kernel_launch(void* const* d_in, const int* in_sizes, int n_in, void* d_out, int out_size, void* d_ws, size_t ws_size, hipStream_t stream) {
    static int grid = 0;
    if (grid == 0) {
        if (n_in != 27 || ws_size < WS_END) { fprintf(stderr, "kernel_launch: unexpected n_in %d / ws_size %zu (need %zu)\n", n_in, ws_size, (size_t)WS_END); grid = -1; return; }
        if (hipFuncSetAttribute((const void*)mega_fwd, hipFuncAttributeMaxDynamicSharedMemorySize, LDS_BYTES) != hipSuccess) { fprintf(stderr, "kernel_launch: hipFuncSetAttribute failed\n"); grid = -1; return; }
        int dev = 0, cus = 0, per_cu = 0;
        hipGetDevice(&dev); hipDeviceGetAttribute(&cus, hipDeviceAttributeMultiprocessorCount, dev);
        hipOccupancyMaxActiveBlocksPerMultiprocessor(&per_cu, (const void*)mega_fwd, 512, LDS_BYTES);
        (void)hipGetLastError();
        if (per_cu < 1) per_cu = 1;
        grid = cus * per_cu; if (grid > 256) grid = 256; grid &= ~7;
        if (grid < 8) grid = 8;
    }
    if (grid < 0) return;
    Params p{};
    for (int i = 0; i < 27; ++i) p.in[i] = (const float*)d_in[i];
    p.out = (float*)d_out; p.ws = (unsigned char*)d_ws;
#if MK_ONE_LAUNCH
    p.ph_lo = 0; p.ph_hi = NPH;
    void* args[] = {&p};
    hipError_t e = hipLaunchCooperativeKernel((const void*)mega_fwd, dim3(grid), dim3(512), args, LDS_BYTES, stream);
    if (e != hipSuccess) fprintf(stderr, "cooperative launch failed: %s (grid %d)\n", hipGetErrorString(e), grid);
#else
    for (int ph = 0; ph < NPH; ++ph) { p.ph_lo = ph; p.ph_hi = ph + 1; hipLaunchKernelGGL(mega_fwd, dim3(grid), dim3(512), LDS_BYTES, stream, p); }
#endif
}
```

```cpp
#include <hip/hip_runtime.h>
#include <hip/hip_cooperative_groups.h>
#include <cstdio>
#include <cstdint>
namespace cg = cooperative_groups;

#ifndef MK_ONE_LAUNCH
#define MK_ONE_LAUNCH 1
#endif

typedef unsigned short bf16_t;
typedef short bf16x8 __attribute__((ext_vector_type(8)));
typedef short s16x4 __attribute__((ext_vector_type(4)));
typedef float f32x4 __attribute__((ext_vector_type(4)));
typedef unsigned u32x4 __attribute__((ext_vector_type(4)));
typedef unsigned u32x2 __attribute__((ext_vector_type(2)));
typedef short v4i16_t __attribute__((ext_vector_type(4)));
#define LAS __attribute__((address_space(3)))

constexpr int T = 49152, TP = 16384, NMEMTOK = 2048;
constexpr int LDP = 2048;
#ifdef SPLIT_AB
constexpr int NPH_LAYER = 20, NPH = 2 * NPH_LAYER;
#else
constexpr int NPH_LAYER = 19, NPH = 2 * NPH_LAYER;
#endif
constexpr float EPS = 1e-6f;
constexpr float LOG2E = 1.4426950408889634f;

constexpr size_t W_IN_E = 2048ull * 1024, W_QKV_E = 2048ull * 384, W_OUT_E = 1024ull * 1024, W_MQ_E = 512ull * 1024,
                 W_MKV_E = 1024ull * 1024, W_MO_E = 1024ull * 512, W_1_E = 4096ull * 1024, W_2_E = 1024ull * 4096;
constexpr size_t WO_IN = 0, WO_QKV = WO_IN + W_IN_E, WO_OUT = WO_QKV + W_QKV_E, WO_MQ = WO_OUT + W_OUT_E, WO_MKV = WO_MQ + W_MQ_E,
                 WO_MO = WO_MKV + W_MKV_E, WO_1 = WO_MO + W_MO_E, WO_2 = WO_1 + W_1_E, W_LAYER_E = WO_2 + W_2_E;
constexpr size_t OFF_W = 0, OFF_CS = OFF_W + 2 * W_LAYER_E * 2, OFF_MM = OFF_CS + 8192ull * 16 * 8, OFF_KVM = OFF_MM + 2 * 2048ull * 1024 * 2,
                 OFF_RA = OFF_KVM + 2048ull * 1024 * 2, OFF_RB = OFF_RA + (size_t)T * 2048 * 2, OFF_BAR = OFF_RB + (size_t)T * 2048 * 2, OFF_SS = OFF_BAR + 16384, WS_END = OFF_SS + (size_t)T * 16 * 4;
constexpr int LDS_BYTES = 155648;

struct Params { const float* in[27]; float* out; unsigned char* ws; int ph_lo, ph_hi; };

extern __shared__ __attribute__((aligned(16))) unsigned char smem[];
typedef const __attribute__((address_space(4))) Params* PP;
struct Ctx { int tid, bid, nb; };

typedef float f32x2_t __attribute__((ext_vector_type(2)));
typedef __bf16 bf16x2_t __attribute__((ext_vector_type(2)));
__device__ __forceinline__ unsigned cvtpk(float lo, float hi) { const f32x2_t v = {lo, hi}; return __builtin_bit_cast(unsigned, __builtin_convertvector(v, bf16x2_t)); }
__device__ __forceinline__ float bflo(unsigned u) { return __uint_as_float(u << 16); }
__device__ __forceinline__ float bfhi(unsigned u) { return __uint_as_float(u & 0xffff0000u); }
__device__ __forceinline__ void unpack8(const u32x4 v, float* f) {
#pragma unroll
    for (int i = 0; i < 4; ++i) { f[2 * i] = bflo(v[i]); f[2 * i + 1] = bfhi(v[i]); } }
__device__ __forceinline__ u32x4 pack8(const float* f) { u32x4 r; r.x = cvtpk(f[0], f[1]); r.y = cvtpk(f[2], f[3]); r.z = cvtpk(f[4], f[5]); r.w = cvtpk(f[6], f[7]); return r; }
__device__ __forceinline__ float shx(float v, int m, int lane) { return __int_as_float(__builtin_amdgcn_ds_bpermute((lane ^ m) << 2, __float_as_int(v))); }
__device__ __forceinline__ float shl(float v, int src) { return __int_as_float(__builtin_amdgcn_ds_bpermute(src << 2, __float_as_int(v))); }
__device__ __forceinline__ float wave_sum(float v, int lane) {
#pragma unroll
    for (int o = 32; o >= 1; o >>= 1) v += shx(v, o, lane);
    return v; }
template <int CTRL> __device__ __forceinline__ float dppf(float x) { return __builtin_bit_cast(float, __builtin_amdgcn_mov_dpp(__builtin_bit_cast(int, x), CTRL, 0xf, 0xf, true)); }
constexpr int DPP_XOR1 = 0xB1, DPP_XOR2 = 0x4E, DPP_XOR7 = 0x141, DPP_XOR8 = 0x128;
__device__ __forceinline__ float sum8(float v) { v += dppf<DPP_XOR1>(v); v += dppf<DPP_XOR2>(v); v += dppf<DPP_XOR7>(v); return v; }
__device__ __forceinline__ float sum16(float v) { v = sum8(v); v += dppf<DPP_XOR8>(v); return v; }
__device__ __forceinline__ float sum64(float v, int lane) { v = sum16(v); v += shx(v, 16, lane); v += shx(v, 32, lane); return v; }
__device__ __forceinline__ void seq_of_tok(int tok, int& seqbase, int& S) {
    if (tok < TP) { seqbase = tok & ~4095; S = 4096; } else { seqbase = TP + ((tok - TP) & ~8191); S = 8192; } }

namespace g8 {
constexpr int BM = 256, BK = 64, HALF = 128, HT = HALF * BK;
__device__ __forceinline__ int lds_byte(int r, int c) { int st = (r >> 4) * 2 + (c >> 5), rr = r & 15, cc = c & 31, ob = rr * 64 + cc * 2; return st * 1024 + (ob ^ (((ob >> 9) & 1) << 5)); }
__device__ __forceinline__ void stage_rc(int b, int& R, int& C) { int st = b / 1024, sb = b % 1024, swz = sb ^ (((sb >> 9) & 1) << 5); R = (st >> 1) * 16 + swz / 64; C = (st & 1) * 32 + (swz % 64) / 2; }

__device__ __forceinline__ int perm32(int rho) { const int n = rho >> 4, i = rho & 15; return 8 * (i >> 2) + 4 * n + (i & 3); }
struct EpiBf16 { bf16_t* O; int ldc; int relu2; const float* ss; int ssrow0;
    __device__ __forceinline__ void operator()(const f32x4 (&acc)[2][2][4][2], int brow, int bcol, int wr, int wc, int fr, int fq, int lane) const {
#pragma unroll
        for (int ai = 0; ai < 2; ++ai) {
            float rs[4];
            if (ss) {
                f32x4 sv[4][4];
#pragma unroll
                for (int m = 0; m < 4; ++m) { const f32x4* sp = (const f32x4*)(ss + (size_t)(ssrow0 + brow + ai * HALF + wr * 64 + m * 16 + fr) * 16);
#pragma unroll
                    for (int i = 0; i < 4; ++i) sv[m][i] = sp[i]; }
#pragma unroll
                for (int m = 0; m < 4; ++m) { const f32x4 t = (sv[m][0] + sv[m][1]) + (sv[m][2] + sv[m][3]); rs[m] = rsqrtf(((t[0] + t[1]) + (t[2] + t[3])) * (1.0f / 1024.0f) + EPS); }
            } else {
#pragma unroll
                for (int m = 0; m < 4; ++m) rs[m] = 1.0f;
            }
#pragma unroll
            for (int m = 0; m < 4; ++m) { const int rl = brow + ai * HALF + wr * 64 + m * 16 + fr; bf16_t* rp = O + (size_t)rl * ldc + bcol + wc * 32 + fq * 8;
#pragma unroll
                for (int bj = 0; bj < 2; ++bj) { f32x4 v0 = acc[ai][bj][m][0] * rs[m], v1 = acc[ai][bj][m][1] * rs[m];
                    if (relu2) {
#pragma unroll
                        for (int j = 0; j < 4; ++j) { float t = v0[j] > 0.f ? v0[j] : 0.f; v0[j] = t * t; t = v1[j] > 0.f ? v1[j] : 0.f; v1[j] = t * t; } }
                    u32x4 w; w.x = cvtpk(v0[0], v0[1]); w.y = cvtpk(v0[2], v0[3]); w.z = cvtpk(v1[0], v1[1]); w.w = cvtpk(v1[2], v1[3]); *(u32x4*)(rp + bj * HALF) = w; } }
            __builtin_amdgcn_sched_barrier(0);
        } } };
struct EpiRes { const float* x0; const float* x1; int split; float* out; int rowoff; bf16_t* xb; float* ss;
    __device__ __forceinline__ void operator()(const f32x4 (&acc)[2][2][4][2], int brow, int bcol, int wr, int wc, int fr, int fq, int lane) const {
#pragma unroll
        for (int ai = 0; ai < 2; ++ai) {
            f32x4 xv[4][2][2];
#pragma unroll
            for (int m = 0; m < 4; ++m) { const int row = rowoff + brow + ai * HALF + wr * 64 + m * 16 + fr; const int c0 = bcol + wc * 32 + fq * 8;
                const float* xp = (row < split ? x0 + (size_t)row * 1024 : x1 + (size_t)(row - split) * 1024) + c0;
#pragma unroll
                for (int bj = 0; bj < 2; ++bj) { xv[m][bj][0] = *(const f32x4*)(xp + bj * HALF); xv[m][bj][1] = *(const f32x4*)(xp + bj * HALF + 4); } }
            float sq[4];
#pragma unroll
            for (int m = 0; m < 4; ++m) { const int row = rowoff + brow + ai * HALF + wr * 64 + m * 16 + fr; const int c0 = bcol + wc * 32 + fq * 8;
                float* op = out + (size_t)row * 1024 + c0; bf16_t* bp = xb + (size_t)row * 1024 + c0; sq[m] = 0.f;
#pragma unroll
                for (int bj = 0; bj < 2; ++bj) { const f32x4 v0 = xv[m][bj][0] + acc[ai][bj][m][0], v1 = xv[m][bj][1] + acc[ai][bj][m][1];
                    *(f32x4*)(op + bj * HALF) = v0; *(f32x4*)(op + bj * HALF + 4) = v1;
                    u32x4 w; w.x = cvtpk(v0[0], v0[1]); w.y = cvtpk(v0[2], v0[3]); w.z = cvtpk(v1[0], v1[1]); w.w = cvtpk(v1[2], v1[3]); *(u32x4*)(bp + bj * HALF) = w;
                    sq[m] += (v0[0] * v0[0] + v0[1] * v0[1]) + (v0[2] * v0[2] + v0[3] * v0[3]) + (v1[0] * v1[0] + v1[1] * v1[1]) + (v1[2] * v1[2] + v1[3] * v1[3]); } }
#pragma unroll
            for (int m = 0; m < 4; ++m) sq[m] += shx(sq[m], 16, lane);
#pragma unroll
            for (int m = 0; m < 4; ++m) sq[m] += shx(sq[m], 32, lane);
            if (fq == 0) {
#pragma unroll
                for (int m = 0; m < 4; ++m) ss[(size_t)(rowoff + brow + ai * HALF + wr * 64 + m * 16 + fr) * 16 + (bcol >> 8) * 4 + wc] = sq[m]; }
            __builtin_amdgcn_sched_barrier(0); } } };
struct EpiAny { int mode; EpiBf16 eb; EpiRes er;
    __device__ __forceinline__ void operator()(const f32x4 (&acc)[2][2][4][2], int brow, int bcol, int wr, int wc, int fr, int fq, int lane) const {
        if (mode == 2) er(acc, brow, bcol, wr, wc, fr, fq, lane); else eb(acc, brow, bcol, wr, wc, fr, fq, lane); } };
struct GemmDesc { const bf16_t* A; const bf16_t* Bt; int lda, ldb, M, N, K, rev; EpiAny epi; };

template <class Epi>
__device__ __forceinline__ void gemm_phase(const Ctx& cx, const bf16_t* A, int lda, const bf16_t* Bt, int ldb, int M, int N, int K, const Epi& epi, int rev = 0) {
    const int nM = M / BM, nN = N / BM, b = cx.bid, per = (nM >> 3) * nN, step = cx.nb >> 3;
    int w = rev ? (step - 1 - (b >> 3)) : (b >> 3);
    if (w >= per) return;
    unsigned voffA[2], voffB[2];
#pragma unroll
    for (int i = 0; i < 2; ++i) { int R, C; stage_rc(cx.tid * 16 + i * 8192, R, C); voffA[i] = (unsigned)(R * lda + C) * 2u; voffB[i] = (unsigned)(((R & ~31) + perm32(R & 31)) * ldb + C) * 2u; }
    const size_t hstepA = (size_t)HALF * lda * 2, hstepB = (size_t)HALF * ldb * 2;
    LAS unsigned char* lds = (LAS unsigned char*)smem;
    constexpr int HTB = HT * 2;
    constexpr size_t kstep = BK * 2;
    const int nt = K / BK;
#define SA(b, h) (((b) * 2 + (h)) * HTB)
#define SB(b, h) ((4 + (b) * 2 + (h)) * HTB)
#define STAGE(bufoff, gbase, voff) do { _Pragma("unroll") for (int _i = 0; _i < 2; ++_i) \
      __builtin_amdgcn_global_load_lds((const unsigned*)((const char*)(gbase) + (voff)[_i]), (LAS unsigned*)(lds + (bufoff) + ldsw + _i * 8192), 16, 0, 0); } while (0)
#define LDA(dst, b, h) do { _Pragma("unroll") for (int m = 0; m < 4; ++m) _Pragma("unroll") for (int k = 0; k < 2; ++k) dst[m][k] = *(const LAS bf16x8*)(lds + SA(b, h) + aoff + m * 2048 + k * 1024); } while (0)
#define LDB(dst, b, h) do { _Pragma("unroll") for (int n = 0; n < 2; ++n) _Pragma("unroll") for (int k = 0; k < 2; ++k) dst[n][k] = *(const LAS bf16x8*)(lds + SB(b, h) + boff + n * 2048 + k * 1024); } while (0)
#define MMA(ai, bj, At, Bt_) do { __builtin_amdgcn_s_setprio(1); _Pragma("unroll") for (int m = 0; m < 4; ++m) _Pragma("unroll") for (int n = 0; n < 2; ++n) _Pragma("unroll") for (int k = 0; k < 2; ++k) \
      acc[ai][bj][m][n] = __builtin_amdgcn_mfma_f32_16x16x32_bf16(Bt_[n][k], At[m][k], acc[ai][bj][m][n], 0, 0, 0); \
    __builtin_amdgcn_s_setprio(0); } while (0)
#define WAIT_V(n) asm volatile("s_waitcnt vmcnt(" #n ")" ::: "memory")
#define WAIT_L(n) asm volatile("s_waitcnt lgkmcnt(" #n ")" ::: "memory")
#define BAR __builtin_amdgcn_s_barrier()
#define SCHED __builtin_amdgcn_sched_barrier(0)
#define ZACC do { _Pragma("unroll") for (int a_ = 0; a_ < 2; ++a_) _Pragma("unroll") for (int b_ = 0; b_ < 2; ++b_) _Pragma("unroll") for (int m = 0; m < 4; ++m) _Pragma("unroll") for (int n = 0; n < 2; ++n) acc[a_][b_][m][n] = (f32x4){0.f, 0.f, 0.f, 0.f}; } while (0)
    const int wid = __builtin_amdgcn_readfirstlane(cx.tid >> 6), lane = cx.tid & 63, wr = wid >> 2, wc = wid & 3, fr = lane & 15, fq = lane >> 4;
    const unsigned ldsw = (unsigned)wid * 1024u;
    const int aoff = lds_byte(wr * 64 + fr, fq * 8), boff = lds_byte(wc * 32 + fr, fq * 8);
    f32x4 acc[2][2][4][2];
    ZACC;
    bf16x8 At[4][2], B0[2][2], B1[2][2];
    int pm = (b & 7) + 8 * (w / nN), pn = w % nN;
    const char* cA = (const char*)A + (size_t)pm * 2 * hstepA; const char* cB = (const char*)Bt + (size_t)pn * 2 * hstepB;
    STAGE(SB(0, 0), cB, voffB); STAGE(SA(0, 0), cA, voffA);
    STAGE(SB(0, 1), cB + hstepB, voffB); STAGE(SA(0, 1), cA + hstepA, voffA);
    if (wr == 1) BAR;
    WAIT_V(4); BAR;
    STAGE(SB(1, 0), cB + kstep, voffB); STAGE(SA(1, 0), cA + kstep, voffA); STAGE(SB(1, 1), cB + hstepB + kstep, voffB);
    WAIT_V(6); BAR;
    for (;;) {
        const int wn = w + step; const bool has_next = wn < per;
        const int pmn = (b & 7) + 8 * (wn / nN), pnn = wn % nN;
        const char* nA = has_next ? (const char*)A + (size_t)pmn * 2 * hstepA : cA; const char* nB = has_next ? (const char*)Bt + (size_t)pnn * 2 * hstepB : cB;
        for (int t = 0; t < nt; t += 2) {
            const bool last = (t == nt - 2);
            const char* a1 = cA + (size_t)(t + 1) * kstep;
            const char* a2 = last ? nA : cA + (size_t)(t + 2) * kstep; const char* b2 = last ? nB : cB + (size_t)(t + 2) * kstep;
            const char* a3 = a2 + kstep; const char* b3 = b2 + kstep;
            LDB(B0, 0, 0); SCHED; LDA(At, 0, 0); STAGE(SA(1, 1), a1 + hstepA, voffA);
            WAIT_L(8); BAR; WAIT_L(0); MMA(0, 0, At, B0); BAR; SCHED;
            LDB(B1, 0, 1); STAGE(SB(0, 0), b2, voffB);
            BAR; WAIT_L(0); MMA(0, 1, At, B1); BAR;
            LDA(At, 0, 1); STAGE(SA(0, 0), a2, voffA);
            BAR; WAIT_L(0); MMA(1, 0, At, B0); BAR; SCHED;
            STAGE(SB(0, 1), b2 + hstepB, voffB);
            WAIT_V(6); BAR; MMA(1, 1, At, B1); BAR;
            LDB(B0, 1, 0); SCHED; LDA(At, 1, 0); STAGE(SA(0, 1), a2 + hstepA, voffA);
            WAIT_L(8); BAR; WAIT_L(0); MMA(0, 0, At, B0); BAR; SCHED;
            LDB(B1, 1, 1); STAGE(SB(1, 0), b3, voffB);
            BAR; WAIT_L(0); MMA(0, 1, At, B1); BAR;
            LDA(At, 1, 1); STAGE(SA(1, 0), a3, voffA);
            BAR; WAIT_L(0); MMA(1, 0, At, B0); BAR; SCHED;
            STAGE(SB(1, 1), b3 + hstepB, voffB);
            WAIT_V(6); BAR; MMA(1, 1, At, B1); BAR;
        }
        epi(acc, pm * BM, pn * BM, wr, wc, fr, fq, lane);
        if (!has_next) break;
        ZACC;
        w = wn; pm = pmn; pn = pnn; cA = nA; cB = nB;
    }
    WAIT_V(0);
    if (wr == 0) BAR;
    BAR;
#undef SA
#undef SB
#undef STAGE
#undef LDA
#undef LDB
#undef MMA
#undef ZACC
}
}

__device__ __forceinline__ void norm_rows(const Ctx& cx, const float* src0, const float* src1, int split, const float* __restrict__ g, bf16_t* dst, int nrows) {
    const int lane = cx.tid & 63, gw = cx.bid * 8 + (cx.tid >> 6), nw = cx.nb * 8;
    f32x4 gv[4];
#pragma unroll
    for (int i = 0; i < 4; ++i) gv[i] = *(const f32x4*)(g + i * 256 + lane * 4);
    for (int row = gw; row < nrows; row += nw) {
        const float* s = row < split ? src0 + (size_t)row * 1024 : src1 + (size_t)(row - split) * 1024;
        f32x4 v[4]; float ss = 0.f;
#pragma unroll
        for (int i = 0; i < 4; ++i) { v[i] = *(const f32x4*)(s + i * 256 + lane * 4); ss += v[i][0] * v[i][0] + v[i][1] * v[i][1] + v[i][2] * v[i][2] + v[i][3] * v[i][3]; }
        ss = wave_sum(ss, lane);
        const float rs = rsqrtf(ss * (1.0f / 1024.0f) + EPS);
#pragma unroll
        for (int i = 0; i < 4; ++i) { u32x2 w; w.x = cvtpk(v[i][0] * rs * gv[i][0], v[i][1] * rs * gv[i][1]); w.y = cvtpk(v[i][2] * rs * gv[i][2], v[i][3] * rs * gv[i][3]);
            *(u32x2*)(dst + (size_t)row * 1024 + i * 256 + lane * 4) = w; }
    }
}

__device__ __forceinline__ void xcast_rows(const Ctx& cx, const float* src0, const float* src1, int split, bf16_t* dst, float* ss, int nrows) {
    const int lane = cx.tid & 63, gw = cx.bid * 8 + (cx.tid >> 6), nw = cx.nb * 8;
    for (int row = gw; row < nrows; row += nw) {
        const float* sp = row < split ? src0 + (size_t)row * 1024 : src1 + (size_t)(row - split) * 1024;
        f32x4 v[4]; float sq = 0.f;
#pragma unroll
        for (int i = 0; i < 4; ++i) { v[i] = *(const f32x4*)(sp + i * 256 + lane * 4); sq += v[i][0] * v[i][0] + v[i][1] * v[i][1] + v[i][2] * v[i][2] + v[i][3] * v[i][3]; }
        sq = wave_sum(sq, lane);
#pragma unroll
        for (int i = 0; i < 4; ++i) { u32x2 w; w.x = cvtpk(v[i][0], v[i][1]); w.y = cvtpk(v[i][2], v[i][3]); *(u32x2*)(dst + (size_t)row * 1024 + i * 256 + lane * 4) = w; }
        if (lane < 16) ss[(size_t)row * 16 + lane] = lane == 0 ? sq : 0.f;
    }
}

template <class F>
__device__ __forceinline__ void wconv(const Ctx& cx, bf16_t* dst, int Np, int Kp, F src) {
    LAS unsigned char* lds = (LAS unsigned char*)smem;
    const int tid = cx.tid, tn = Np >> 6, tk = Kp >> 6, ntile = tn * tk;
    const int rk = tid >> 3, rn8 = (tid & 7) * 8;
    for (int t = cx.bid; t < ntile; t += cx.nb) {
        const int n0 = (t % tn) << 6, k0 = (t / tn) << 6;
#pragma unroll
        for (int i = 0; i < 8; ++i) { const float v = src(n0 + rn8 + i, k0 + rk); const unsigned w = cvtpk(v, 0.f);
            *(LAS unsigned short*)(lds + (rn8 + i) * 144 + rk * 2) = (unsigned short)w; }
        __syncthreads();
        const u32x4 o = *(const LAS u32x4*)(lds + rk * 144 + rn8 * 2);
        *(u32x4*)(dst + (size_t)(n0 + rk) * Kp + k0 + rn8) = o;
        __syncthreads();
    }
}

__device__ __forceinline__ void prologue(const Ctx& cx, PP p) {
    bf16_t* W = (bf16_t*)(p->ws + OFF_W);
    for (int l = 0; l < 2; ++l) {
        bf16_t* Wl = W + (size_t)l * W_LAYER_E;
        { const float* s = p->in[5] + (size_t)l * 1024 * 1952; const float* g = p->in[4] + l * 1024; wconv(cx, Wl + WO_IN, 2048, 1024, [=](int n, int k) -> float { return n < 1952 ? s[(size_t)k * 1952 + n] * g[k] : 0.f; }); }
        { const float* uq = p->in[10] + (size_t)l * 256 * 768; const float* ukv = p->in[11] + (size_t)l * 128 * 1024;
          wconv(cx, Wl + WO_QKV, 2048, 384, [=](int n, int k) -> float { const int h = n >> 8, j = n & 255;
              if (j < 96) return k < 256 ? uq[(size_t)k * 768 + h * 96 + j] : 0.f;
              if (j < 160) return k >= 256 ? ukv[(size_t)(k - 256) * 1024 + h * 128 + (j - 96)] : 0.f;
              if (j < 192) return 0.f;
              return k >= 256 ? ukv[(size_t)(k - 256) * 1024 + h * 128 + 64 + (j - 192)] : 0.f; }); }
        { const float* s = p->in[16] + (size_t)l * 1024 * 1024; wconv(cx, Wl + WO_OUT, 1024, 1024, [=](int n, int k) -> float { return s[(size_t)k * 1024 + n]; }); }
        { const float* s = p->in[19] + (size_t)l * 1024 * 512; const float* g = p->in[17] + l * 1024; wconv(cx, Wl + WO_MQ, 512, 1024, [=](int n, int k) -> float { return s[(size_t)k * 512 + n] * g[k]; }); }
        { const float* s = p->in[20] + (size_t)l * 1024 * 1024; wconv(cx, Wl + WO_MKV, 1024, 1024, [=](int n, int k) -> float { return s[(size_t)k * 1024 + n]; }); }
        { const float* s = p->in[23] + (size_t)l * 512 * 1024; wconv(cx, Wl + WO_MO, 1024, 512, [=](int n, int k) -> float { return s[(size_t)k * 1024 + n]; }); }
        { const float* s = p->in[25] + (size_t)l * 1024 * 4096; const float* g = p->in[24] + l * 1024; wconv(cx, Wl + WO_1, 4096, 1024, [=](int n, int k) -> float { return s[(size_t)k * 4096 + n] * g[k]; }); }
        { const float* s = p->in[26] + (size_t)l * 4096 * 1024; wconv(cx, Wl + WO_2, 1024, 4096, [=](int n, int k) -> float { return s[(size_t)k * 1024 + n]; }); }
    }
    float2* cs = (float2*)(p->ws + OFF_CS);
    const int gt = cx.bid * 512 + cx.tid, nt = cx.nb * 512;
    for (int idx = gt; idx < 8192 * 16; idx += nt) { const int pos = idx >> 4, j = idx & 15;
        double inv = 1.0; for (int k = 0; k < j; ++k) inv *= 0.44036660267178046;
        double tt = (double)pos * inv * 0.15915494309189535; tt -= floor(tt);
        const float fr = (float)tt; cs[idx] = make_float2(__builtin_amdgcn_cosf(fr), __builtin_amdgcn_sinf(fr)); }
}

__device__ __forceinline__ void prep_a(const Ctx& cx, PP p, int l) {
    bf16_t* PROJ = (bf16_t*)(p->ws + OFF_RA); bf16_t* KVM = (bf16_t*)(p->ws + OFF_KVM); const float2* cs = (const float2*)(p->ws + OFF_CS);
    const int lane = cx.tid & 63, gw = cx.bid * 8 + (cx.tid >> 6), nw = cx.nb * 8;
    const int seg = lane & 7;
    float gq[8], gk[8], gcq[4], gckv[2], gkm[8];
#pragma unroll
    for (int i = 0; i < 8; ++i) { gq[i] = p->in[6][l * 64 + seg * 8 + i]; gk[i] = p->in[7][l * 64 + seg * 8 + i]; gkm[i] = p->in[22][l * 128 + (lane & 15) * 8 + i]; }
#pragma unroll
    for (int i = 0; i < 4; ++i) gcq[i] = p->in[8][l * 256 + lane * 4 + i];
    gckv[0] = p->in[9][l * 128 + lane * 2]; gckv[1] = p->in[9][l * 128 + lane * 2 + 1];
    const float qscale = 0.125f * LOG2E;
    for (int tok = gw; tok < T; tok += nw) {
        int seqbase, S; seq_of_tok(tok, seqbase, S); const int pos = tok - seqbase;
        bf16_t* R = PROJ + (size_t)tok * LDP;
        float2 c = make_float2(1.f, 0.f);
        float cc[8], sn[8];
#pragma unroll
        for (int i = 0; i < 8; ++i) { const float2 t = cs[pos * 16 + 2 * i]; cc[i] = seg < 2 ? t.x : 1.0f; sn[i] = seg == 0 ? -t.y : (seg == 1 ? t.y : 0.0f); }
        (void)c;
#pragma unroll
        for (int which = 0; which < 2; ++which) {
            bf16_t* ptr = R + which * 512 + lane * 8; float f[8]; unpack8(*(const u32x4*)ptr, f);
            float ss = 0.f;
#pragma unroll
            for (int i = 0; i < 8; ++i) ss += f[i] * f[i];
            ss = sum8(ss);
            const float rs = rsqrtf(ss * (1.0f / 64.0f) + EPS);
#pragma unroll
            for (int i = 0; i < 8; ++i) f[i] = f[i] * rs * (which == 0 ? gq[i] : gk[i]);
            float o[8];
#pragma unroll
            for (int i = 0; i < 8; ++i) { const float pr = dppf<DPP_XOR1>(f[i]); o[i] = f[i] * cc[i] + pr * sn[i]; }
            if (which == 0) {
#pragma unroll
                for (int i = 0; i < 8; ++i) o[i] *= qscale; }
            *(u32x4*)ptr = pack8(o);
        }
        { bf16_t* ptr = R + 1536 + lane * 4; const u32x2 v = *(const u32x2*)ptr; float f[4] = {bflo(v.x), bfhi(v.x), bflo(v.y), bfhi(v.y)};
          float ss = sum64(f[0] * f[0] + f[1] * f[1] + f[2] * f[2] + f[3] * f[3], lane); const float rs = rsqrtf(ss * (1.0f / 256.0f) + EPS);
          u32x2 w; w.x = cvtpk(f[0] * rs * gcq[0], f[1] * rs * gcq[1]); w.y = cvtpk(f[2] * rs * gcq[2], f[3] * rs * gcq[3]); *(u32x2*)ptr = w; }
        { bf16_t* ptr = R + 1792 + lane * 2; const unsigned v = *(const unsigned*)ptr; float f0 = bflo(v), f1 = bfhi(v);
          float ss = sum64(f0 * f0 + f1 * f1, lane); const float rs = rsqrtf(ss * (1.0f / 128.0f) + EPS);
          *(unsigned*)ptr = cvtpk(f0 * rs * gckv[0], f1 * rs * gckv[1]); }
    }
}

__device__ __forceinline__ void prep_b(const Ctx& cx, PP p, int l) {
    const bf16_t* PROJ = (const bf16_t*)(p->ws + OFF_RA); bf16_t* QKVB = (bf16_t*)(p->ws + OFF_RB); const float2* cs = (const float2*)(p->ws + OFF_CS);
    const int lane = cx.tid & 63, gw = cx.bid * 8 + (cx.tid >> 6), nw = cx.nb * 8;
    const int h = lane >> 3, seg = lane & 7; const bool active = seg < 6; const int sg = active ? seg : 5;
    float gq[16], gk[16];
#pragma unroll
    for (int i = 0; i < 16; ++i) { gq[i] = p->in[12][l * 96 + sg * 16 + i]; gk[i] = p->in[13][l * 96 + sg * 16 + i]; }
    const float qscale = 0.10206207261596577f * LOG2E;
    for (int tok = gw; tok < T; tok += nw) {
        int seqbase, S; seq_of_tok(tok, seqbase, S); const int pos = tok - seqbase;
        bf16_t* R = QKVB + (size_t)tok * LDP + h * 256;
        float cm[16], sm[16];
#pragma unroll
        for (int i = 0; i < 16; ++i) { const float2 t = cs[pos * 16 + i]; cm[i] = seg == 4 || seg == 5 ? t.x : 1.0f; sm[i] = seg == 4 ? -t.y : (seg == 5 ? t.y : 0.0f); }
#pragma unroll
        for (int which = 0; which < 2; ++which) {
            const bf16_t* src = which == 0 ? R + sg * 16 : (sg < 4 ? R + 96 + sg * 16 : PROJ + (size_t)tok * LDP + 1920 + (sg - 4) * 16);
            bf16_t* dst = R + which * 96 + sg * 16;
            float f[16]; unpack8(*(const u32x4*)src, f); unpack8(*(const u32x4*)(src + 8), f + 8);
            float ss = 0.f;
#pragma unroll
            for (int i = 0; i < 16; ++i) ss += f[i] * f[i];
            const float tot = sum8(active ? ss : 0.f);
            const float rs = rsqrtf(tot * (1.0f / 96.0f) + EPS);
#pragma unroll
            for (int i = 0; i < 16; ++i) f[i] = f[i] * rs * (which == 0 ? gq[i] : gk[i]);
            float o[16];
#pragma unroll
            for (int i = 0; i < 16; ++i) { const float pr = dppf<DPP_XOR1>(f[i]); o[i] = f[i] * cm[i] + pr * sm[i]; }
            if (which == 0) {
#pragma unroll
                for (int i = 0; i < 16; ++i) o[i] *= qscale; }
            if (active) { *(u32x4*)dst = pack8(o); *(u32x4*)(dst + 8) = pack8(o + 8); }
        }
    }
}

__device__ __forceinline__ void out_norm(const Ctx& cx, PP p, int l) {
    bf16_t* PROJ = (bf16_t*)(p->ws + OFF_RA);
    const int lane = cx.tid & 63, gw = cx.bid * 8 + (cx.tid >> 6), nw = cx.nb * 8;
    float ga[8], gb[8];
#pragma unroll
    for (int i = 0; i < 8; ++i) { ga[i] = p->in[14][l * 512 + lane * 8 + i]; gb[i] = p->in[15][l * 512 + lane * 8 + i]; }
    for (int tok = gw; tok < T; tok += nw) {
        bf16_t* R = PROJ + (size_t)tok * LDP; float a[8], b[8];
        unpack8(*(const u32x4*)(R + lane * 8), a); unpack8(*(const u32x4*)(R + 1536 + lane * 8), b);
        float sa = 0.f, sb = 0.f;
#pragma unroll
        for (int i = 0; i < 8; ++i) { sa += a[i] * a[i]; sb += b[i] * b[i]; }
        sa = sum64(sa, lane); sb = sum64(sb, lane);
        const float ra = rsqrtf(sa * (1.0f / 512.0f) + EPS), rb = rsqrtf(sb * (1.0f / 512.0f) + EPS);
#pragma unroll
        for (int i = 0; i < 8; ++i) { a[i] = a[i] * ra * ga[i]; b[i] = b[i] * rb * gb[i]; }
        *(u32x4*)(R + lane * 8) = pack8(a); *(u32x4*)(R + 512 + lane * 8) = pack8(b);
    }
}

#define MFMA16(a, b, c) __builtin_amdgcn_mfma_f32_16x16x32_bf16(a, b, c, 0, 0, 0)
__device__ __forceinline__ s16x4 vtr(const LAS unsigned char* p) { return __builtin_bit_cast(s16x4, __builtin_amdgcn_ds_read_tr16_b64_v4i16((LAS v4i16_t*)p)); }

template <int DQK, int DV, int KT, int QG, bool QNORM>
__device__ __forceinline__ void attn_dense(const Ctx& cx, const bf16_t* Q, int ldq, const bf16_t* Kb, int ldk, const bf16_t* Vb, int ldv, int nkeys,
                                           bf16_t* O, int ldo, const float* qgain, float qscale) {
    constexpr int KC = DQK / 32, DVT = DV / 16, KSTR = DQK * 2 + 16, VSTR = (DV == 64) ? 160 : 288;
    constexpr int KBUF = KT * KSTR, VBUF = KT * VSTR, STG = KBUF + VBUF;
    constexpr int KCPR = DQK / 8, VCPR = DV / 8, KPER = KT * KCPR / 512, VPER = KT * VCPR / 512;
    static_assert(2 * STG <= LDS_BYTES, "LDS");
    const int tid = cx.tid, wid = tid >> 6, lane = tid & 63, fr = lane & 15, fq = lane >> 4;
    LAS unsigned char* lds = (LAS unsigned char*)smem;
    bf16x8 qf[QG][KC];
#pragma unroll
    for (int qg = 0; qg < QG; ++qg) {
        const bf16_t* qp = Q + (size_t)(wid * 16 * QG + qg * 16 + fr) * ldq;
        if (QNORM) {
            float f[KC][8]; float ss = 0.f;
#pragma unroll
            for (int kc = 0; kc < KC; ++kc) { unpack8(*(const u32x4*)(qp + kc * 32 + fq * 8), f[kc]);
#pragma unroll
                for (int i = 0; i < 8; ++i) ss += f[kc][i] * f[kc][i]; }
            ss += shx(ss, 16, lane); ss += shx(ss, 32, lane);
            const float rs = rsqrtf(ss * (1.0f / DQK) + EPS) * qscale;
#pragma unroll
            for (int kc = 0; kc < KC; ++kc) {
#pragma unroll
                for (int i = 0; i < 8; ++i) f[kc][i] = f[kc][i] * rs * qgain[kc * 32 + fq * 8 + i];
                qf[qg][kc] = __builtin_bit_cast(bf16x8, pack8(f[kc])); }
        } else {
#pragma unroll
            for (int kc = 0; kc < KC; ++kc) qf[qg][kc] = *(const bf16x8*)(qp + kc * 32 + fq * 8);
        }
    }
    float mrun[QG], lrun[QG]; f32x4 o[QG][DVT];
#pragma unroll
    for (int qg = 0; qg < QG; ++qg) { mrun[qg] = -1e30f; lrun[qg] = 0.f;
#pragma unroll
        for (int d = 0; d < DVT; ++d) o[qg][d] = (f32x4){0.f, 0.f, 0.f, 0.f}; }
    u32x4 kreg[KPER], vreg[VPER];
    const int ntiles = nkeys / KT;
#pragma unroll
    for (int i = 0; i < KPER; ++i) { const int c = tid + i * 512, row = c / KCPR, cc = c % KCPR; kreg[i] = *(const u32x4*)(Kb + (size_t)row * ldk + cc * 8); }
#pragma unroll
    for (int i = 0; i < VPER; ++i) { const int c = tid + i * 512, row = c / VCPR, cc = c % VCPR; vreg[i] = *(const u32x4*)(Vb + (size_t)row * ldv + cc * 8); }
#pragma unroll
    for (int i = 0; i < KPER; ++i) { const int c = tid + i * 512, row = c / KCPR, cc = c % KCPR; *(LAS u32x4*)(lds + row * KSTR + cc * 16) = kreg[i]; }
#pragma unroll
    for (int i = 0; i < VPER; ++i) { const int c = tid + i * 512, row = c / VCPR, cc = c % VCPR; *(LAS u32x4*)(lds + KBUF + row * VSTR + cc * 16) = vreg[i]; }
    __syncthreads();
    for (int t = 0; t < ntiles; ++t) {
        const bool more = t + 1 < ntiles;
        if (more) {
            const int k0 = (t + 1) * KT;
#pragma unroll
            for (int i = 0; i < KPER; ++i) { const int c = tid + i * 512, row = c / KCPR, cc = c % KCPR; kreg[i] = *(const u32x4*)(Kb + (size_t)(k0 + row) * ldk + cc * 8); }
#pragma unroll
            for (int i = 0; i < VPER; ++i) { const int c = tid + i * 512, row = c / VCPR, cc = c % VCPR; vreg[i] = *(const u32x4*)(Vb + (size_t)(k0 + row) * ldv + cc * 8); }
        }
        const LAS unsigned char* Kl = lds + (t & 1) * STG; const LAS unsigned char* Vl = Kl + KBUF;
#pragma unroll
        for (int sub = 0; sub < KT / 64; ++sub) {
            f32x4 s[QG][4];
#pragma unroll
            for (int qg = 0; qg < QG; ++qg)
#pragma unroll
                for (int kt = 0; kt < 4; ++kt) s[qg][kt] = (f32x4){0.f, 0.f, 0.f, 0.f};
#pragma unroll
            for (int kt = 0; kt < 4; ++kt)
#pragma unroll
                for (int kc = 0; kc < KC; ++kc) { const bf16x8 a = *(const LAS bf16x8*)(Kl + (sub * 64 + kt * 16 + fr) * KSTR + (kc * 32 + fq * 8) * 2);
#pragma unroll
                    for (int qg = 0; qg < QG; ++qg) s[qg][kt] = MFMA16(a, qf[qg][kc], s[qg][kt]); }
            bf16x8 pb[QG][2];
#pragma unroll
            for (int qg = 0; qg < QG; ++qg) {
                float mx = s[qg][0][0];
#pragma unroll
                for (int kt = 0; kt < 4; ++kt)
#pragma unroll
                    for (int j = 0; j < 4; ++j) mx = fmaxf(mx, s[qg][kt][j]);
                mx = fmaxf(mx, shx(mx, 16, lane)); mx = fmaxf(mx, shx(mx, 32, lane));
                const float mn = fmaxf(mrun[qg], mx), alpha = __builtin_amdgcn_exp2f(mrun[qg] - mn); mrun[qg] = mn;
                float rsum = 0.f;
#pragma unroll
                for (int kt = 0; kt < 4; ++kt)
#pragma unroll
                    for (int j = 0; j < 4; ++j) { const float pv = __builtin_amdgcn_exp2f(s[qg][kt][j] - mn); s[qg][kt][j] = pv; rsum += pv; }
                lrun[qg] = lrun[qg] * alpha + rsum;
#pragma unroll
                for (int d = 0; d < DVT; ++d) o[qg][d] = o[qg][d] * alpha;
#pragma unroll
                for (int t2 = 0; t2 < 2; ++t2) { u32x4 w; w.x = cvtpk(s[qg][2 * t2][0], s[qg][2 * t2][1]); w.y = cvtpk(s[qg][2 * t2][2], s[qg][2 * t2][3]);
                    w.z = cvtpk(s[qg][2 * t2 + 1][0], s[qg][2 * t2 + 1][1]); w.w = cvtpk(s[qg][2 * t2 + 1][2], s[qg][2 * t2 + 1][3]); pb[qg][t2] = __builtin_bit_cast(bf16x8, w); }
            }
#pragma unroll
            for (int t2 = 0; t2 < 2; ++t2)
#pragma unroll
                for (int d = 0; d < DVT; ++d) {
                    const LAS unsigned char* vp = Vl + (sub * 64 + t2 * 32 + fq * 4 + (fr >> 2)) * VSTR + (d * 16 + 4 * (fr & 3)) * 2;
                    const s16x4 lo = vtr(vp), hi = vtr(vp + 16 * VSTR);
                    const bf16x8 a = __builtin_shufflevector(lo, hi, 0, 1, 2, 3, 4, 5, 6, 7);
#pragma unroll
                    for (int qg = 0; qg < QG; ++qg) o[qg][d] = MFMA16(a, pb[qg][t2], o[qg][d]);
                }
        }
        if (more) {
            LAS unsigned char* Kn = lds + ((t + 1) & 1) * STG;
#pragma unroll
            for (int i = 0; i < KPER; ++i) { const int c = tid + i * 512, row = c / KCPR, cc = c % KCPR; *(LAS u32x4*)(Kn + row * KSTR + cc * 16) = kreg[i]; }
#pragma unroll
            for (int i = 0; i < VPER; ++i) { const int c = tid + i * 512, row = c / VCPR, cc = c % VCPR; *(LAS u32x4*)(Kn + KBUF + row * VSTR + cc * 16) = vreg[i]; }
        }
        __syncthreads();
    }
#pragma unroll
    for (int qg = 0; qg < QG; ++qg) {
        float lt = lrun[qg]; lt += shx(lt, 16, lane); lt += shx(lt, 32, lane);
        const float inv = 1.0f / lt;
        bf16_t* op = O + (size_t)(wid * 16 * QG + qg * 16 + fr) * ldo + fq * 4;
#pragma unroll
        for (int d = 0; d < DVT; ++d) { u32x2 w; w.x = cvtpk(o[qg][d][0] * inv, o[qg][d][1] * inv); w.y = cvtpk(o[qg][d][2] * inv, o[qg][d][3] * inv); *(u32x2*)(op + d * 16) = w; }
    }
}

typedef float f32x16 __attribute__((ext_vector_type(16)));
#define MFMA32(a, b, c) __builtin_amdgcn_mfma_f32_32x32x16_bf16(a, b, c, 0, 0, 0)
__device__ __forceinline__ void attn_mla(const Ctx& cx, const bf16_t* Q, const bf16_t* Kb, const bf16_t* Vb, int nkeys, bf16_t* O) {
    constexpr int KT = 128, KSTR = 208, VSTR = 192, KBUF = KT * KSTR, VBUF = KT * VSTR, STG = KBUF + VBUF;
    static_assert(2 * STG <= LDS_BYTES, "LDS");
    const int tid = cx.tid, wid = tid >> 6, lane = tid & 63, c = lane & 31, hi = lane >> 5;
    LAS unsigned char* lds = (LAS unsigned char*)smem;
    bf16x8 qf[6];
    { const bf16_t* qp = Q + (size_t)(wid * 32 + c) * LDP + hi * 8;
#pragma unroll
      for (int kc = 0; kc < 6; ++kc) qf[kc] = *(const bf16x8*)(qp + kc * 16); }
    f32x16 o[2], negm;
#pragma unroll
    for (int i = 0; i < 16; ++i) { o[0][i] = 0.f; o[1][i] = 0.f; negm[i] = 0.f; }
    float lrun = 0.f;
    u32x4 kreg[3], vreg[2];
    const int ntiles = nkeys / KT;
    const bool grpB = false;
    const int koff = c * KSTR + hi * 16;
    const int voff = (4 * hi + ((lane & 15) >> 2)) * VSTR + (((lane >> 4) & 1) * 16 + 4 * (lane & 3)) * 2;
    const unsigned kgo = (unsigned)((tid >> 2) * LDP + (tid & 3) * 8) * 2u, vgo = (unsigned)((tid >> 3) * LDP + (tid & 7) * 8) * 2u;
    const int klo = (tid >> 2) * KSTR + (tid & 3) * 16, vlo = KBUF + (tid >> 3) * VSTR + (tid & 7) * 16;
    const char* Kg = (const char*)Kb; const char* Vg = (const char*)Vb;
#define MLA_GLOAD(k0) do { unsigned kgo_ = kgo, vgo_ = vgo; asm volatile("" : "+v"(kgo_), "+v"(vgo_));   \
    _Pragma("unroll") for (int i = 0; i < 3; ++i) kreg[i] = *(const u32x4*)(Kg + (size_t)(k0) * (LDP * 2) + kgo_ + i * 64); \
    _Pragma("unroll") for (int i = 0; i < 2; ++i) vreg[i] = *(const u32x4*)(Vg + (size_t)((k0) + 64 * i) * (LDP * 2) + vgo_); } while (0)
#define MLA_LWRITE(buf) do { LAS unsigned char* Kn = lds + (buf) * STG; \
    _Pragma("unroll") for (int i = 0; i < 3; ++i) *(LAS u32x4*)(Kn + klo + i * 64) = kreg[i]; \
    _Pragma("unroll") for (int i = 0; i < 2; ++i) *(LAS u32x4*)(Kn + vlo + i * 64 * VSTR) = vreg[i]; } while (0)
#define MLA_QK(dst, kbase) do { _Pragma("unroll") for (int kc = 0; kc < 6; ++kc) { \
        _Pragma("unroll") for (int kb = 0; kb < 2; ++kb) { const bf16x8 a_ = *(const LAS bf16x8*)((kbase) + kb * 32 * KSTR + koff + kc * 32); dst[kb] = MFMA32(a_, qf[kc], kc == 0 ? negm : dst[kb]); } } } while (0)
#define MLA_CHECK(sc) do { float mxl_ = sc[0][0]; \
        _Pragma("unroll") for (int kb = 0; kb < 2; ++kb) _Pragma("unroll") for (int i = 0; i < 16; ++i) mxl_ = fmaxf(mxl_, sc[kb][i]); \
        if (__builtin_amdgcn_ballot_w64(mxl_ > 8.0f) != 0ull) { \
            float dl_ = fmaxf(mxl_, shx(mxl_, 32, lane)); dl_ = fmaxf(dl_, 0.f); const float al_ = __builtin_amdgcn_exp2f(-dl_); lrun *= al_; \
            _Pragma("unroll") for (int i = 0; i < 16; ++i) { o[0][i] *= al_; o[1][i] *= al_; negm[i] -= dl_; sc[0][i] -= dl_; sc[1][i] -= dl_; } } } while (0)
    MLA_GLOAD(0); MLA_LWRITE(0);
    __syncthreads();
    f32x16 sa[2], sb[2];
    MLA_QK(sa, lds);
    {
        float mxl = sa[0][0];
#pragma unroll
        for (int kb = 0; kb < 2; ++kb)
#pragma unroll
            for (int i = 0; i < 16; ++i) mxl = fmaxf(mxl, sa[kb][i]);
        const float mx = fmaxf(mxl, shx(mxl, 32, lane));
#pragma unroll
        for (int i = 0; i < 16; ++i) { negm[i] = -mx; sa[0][i] -= mx; sa[1][i] -= mx; }
    }
    bf16x8 pb[2][2];
#define MLA_EXP(sc) do { float rs_ = 0.f; _Pragma("unroll") for (int kb = 0; kb < 2; ++kb) { \
        _Pragma("unroll") for (int i = 0; i < 16; ++i) { const float pv_ = __builtin_amdgcn_exp2f(sc[kb][i]); sc[kb][i] = pv_; rs_ += pv_; } \
        _Pragma("unroll") for (int t2 = 0; t2 < 2; ++t2) { u32x4 w_; w_.x = cvtpk(sc[kb][8 * t2 + 0], sc[kb][8 * t2 + 1]); w_.y = cvtpk(sc[kb][8 * t2 + 2], sc[kb][8 * t2 + 3]); \
            w_.z = cvtpk(sc[kb][8 * t2 + 4], sc[kb][8 * t2 + 5]); w_.w = cvtpk(sc[kb][8 * t2 + 6], sc[kb][8 * t2 + 7]); pb[kb][t2] = __builtin_bit_cast(bf16x8, w_); } } lrun += rs_; } while (0)
#define MLA_PV(vbase) do { _Pragma("unroll") for (int kb = 0; kb < 2; ++kb) _Pragma("unroll") for (int t2 = 0; t2 < 2; ++t2) _Pragma("unroll") for (int d = 0; d < 2; ++d) { \
        const LAS unsigned char* vp_ = (vbase) + (kb * 32 + t2 * 16) * VSTR + voff + d * 64; const s16x4 lo_ = vtr(vp_), hh_ = vtr(vp_ + 8 * VSTR); \
        o[d] = MFMA32(__builtin_shufflevector(lo_, hh_, 0, 1, 2, 3, 4, 5, 6, 7), pb[kb][t2], o[d]); } } while (0)
#define MLA_SCHED_QK_EXP do { _Pragma("unroll") for (int i_ = 0; i_ < 12; ++i_) { __builtin_amdgcn_sched_group_barrier(0x008, 1, 0); __builtin_amdgcn_sched_group_barrier(0x100, 1, 0); __builtin_amdgcn_sched_group_barrier(0x002, 8, 0); } } while (0)
    for (int t = 0; t < ntiles; ++t) {
        const bool more = t + 1 < ntiles;
        const LAS unsigned char* Kl = lds + (t & 1) * STG; const LAS unsigned char* Vl = Kl + KBUF;
        if (more) MLA_GLOAD((t + 1) * KT);
        if (grpB) { MLA_EXP(sa); MLA_PV(Vl); MLA_QK(sb, Kl + 64 * KSTR); }
        else { MLA_QK(sb, Kl + 64 * KSTR); MLA_EXP(sa); MLA_PV(Vl); }
        MLA_CHECK(sb);
        __syncthreads();
        if (more) MLA_LWRITE((t + 1) & 1);
        __syncthreads();
        if (grpB) { MLA_EXP(sb); MLA_PV(Vl + 64 * VSTR); if (more) { MLA_QK(sa, lds + ((t + 1) & 1) * STG); } }
        else { if (more) { MLA_QK(sa, lds + ((t + 1) & 1) * STG); } MLA_EXP(sb); MLA_PV(Vl + 64 * VSTR); }
        if (more) { MLA_CHECK(sa); }
    }
#undef MLA_GLOAD
#undef MLA_LWRITE
#undef MLA_QK
#undef MLA_CHECK
#undef MLA_EXP
#undef MLA_PV
#undef MLA_SCHED_QK_EXP
    float lt = lrun; lt += shx(lt, 32, lane);
    const float inv = 1.0f / lt;
    int le_; asm volatile("v_mbcnt_lo_u32_b32 %0, -1, 0\n\tv_mbcnt_hi_u32_b32 %0, -1, %0" : "=v"(le_));
    bf16_t* op = O + (size_t)(__builtin_amdgcn_readfirstlane(wid) * 32 + (le_ & 31)) * LDP + 4 * (le_ >> 5);
#pragma unroll
    for (int d = 0; d < 2; ++d)
#pragma unroll
        for (int g = 0; g < 4; ++g) { u32x2 w; w.x = cvtpk(o[d][4 * g] * inv, o[d][4 * g + 1] * inv); w.y = cvtpk(o[d][4 * g + 2] * inv, o[d][4 * g + 3] * inv); *(u32x2*)(op + d * 32 + 8 * g) = w; }
    __syncthreads();
}

template <int MODE>
__device__ __forceinline__ void win_load(const bf16_t* Kbase, const bf16_t* Vbase, int S, int d, int kb, unsigned koff, unsigned voffs, int lane, bf16x8 (&kf)[2][2], u32x4 (&vv)[4]) {
    const int fr = lane & 15, fq = lane >> 4; (void)fr; (void)fq;
    if (MODE == 0) {
#pragma unroll
        for (int kt = 0; kt < 2; ++kt) { int pk = kb + d * (kt * 16 + fr); pk = pk < 0 ? 0 : (pk > S - 1 ? S - 1 : pk);
            const bf16_t* kp = Kbase + (size_t)pk * LDP; kf[kt][0] = *(const bf16x8*)(kp + fq * 8); kf[kt][1] = *(const bf16x8*)(kp + 32 + fq * 8); }
#pragma unroll
        for (int c = 0; c < 4; ++c) { int pk = kb + d * (c * 8 + (lane >> 3)); pk = pk < 0 ? 0 : (pk > S - 1 ? S - 1 : pk);
            vv[c] = *(const u32x4*)(Vbase + (size_t)pk * LDP + (lane & 7) * 8); }
    } else {
#pragma unroll
        for (int kt = 0; kt < 2; ++kt) { const char* ku = (const char*)(Kbase + (size_t)(kb + d * kt * 16) * LDP);
            kf[kt][0] = *(const bf16x8*)(ku + koff); kf[kt][1] = *(const bf16x8*)(ku + 64 + koff); }
#pragma unroll
        for (int c = 0; c < 4; ++c) { const char* vu = (const char*)(Vbase + (size_t)(kb + d * c * 8) * LDP); vv[c] = *(const u32x4*)(vu + voffs); }
    }
}
template <int MODE>
__device__ __forceinline__ void win_compute(int S, int d, int W, int kb, int pq, int i0, const bf16x8 (&kf)[2][2], const u32x4 (&vv)[4],
                                            const bf16x8 (&qf)[2], LAS unsigned char* vl, int lane, float& mrun, float& lrun, f32x4 (&o)[4]) {
    const int fr = lane & 15, fq = lane >> 4;
#pragma unroll
    for (int c = 0; c < 4; ++c) *(LAS u32x4*)(vl + (c * 8 + (lane >> 3)) * 160 + (lane & 7) * 16) = vv[c];
    f32x4 s[2];
#pragma unroll
    for (int kt = 0; kt < 2; ++kt) s[kt] = (f32x4){0.f, 0.f, 0.f, 0.f};
    s[0] = MFMA16(kf[0][0], qf[0], s[0]); s[1] = MFMA16(kf[1][0], qf[0], s[1]); s[0] = MFMA16(kf[0][1], qf[1], s[0]); s[1] = MFMA16(kf[1][1], qf[1], s[1]);
    bool valid[2][4]; float mx = -1e30f;
#pragma unroll
    for (int kt = 0; kt < 2; ++kt)
#pragma unroll
        for (int j = 0; j < 4; ++j) {
            if (MODE == 0) { const int pk = kb + d * (kt * 16 + fq * 4 + j); const int dl = pk - pq; valid[kt][j] = (pk >= 0) && (pk < S) && (dl <= W) && (dl >= -W); }
            else if (MODE == 1) valid[kt][j] = true;
            else if (MODE == 2) valid[kt][j] = (i0 + kt * 16 + fq * 4 + j) >= fr;
            else valid[kt][j] = (i0 + kt * 16 + fq * 4 + j) <= fr + 128;
            if (valid[kt][j]) mx = fmaxf(mx, s[kt][j]); }
    if (__builtin_amdgcn_ballot_w64(mx > mrun + 8.0f) != 0ull) {
        mx = fmaxf(mx, shx(mx, 16, lane)); mx = fmaxf(mx, shx(mx, 32, lane));
        const float mn = fmaxf(mrun, mx), alpha = __builtin_amdgcn_exp2f(mrun - mn); mrun = mn; lrun *= alpha;
#pragma unroll
        for (int dv = 0; dv < 4; ++dv) o[dv] = o[dv] * alpha;
    }
    float rsum = 0.f;
#pragma unroll
    for (int kt = 0; kt < 2; ++kt)
#pragma unroll
        for (int j = 0; j < 4; ++j) { const float pv = valid[kt][j] ? __builtin_amdgcn_exp2f(s[kt][j] - mrun) : 0.f; s[kt][j] = pv; rsum += pv; }
    lrun += rsum;
    u32x4 w; w.x = cvtpk(s[0][0], s[0][1]); w.y = cvtpk(s[0][2], s[0][3]); w.z = cvtpk(s[1][0], s[1][1]); w.w = cvtpk(s[1][2], s[1][3]);
    const bf16x8 pb = __builtin_bit_cast(bf16x8, w);
#pragma unroll
    for (int dv = 0; dv < 4; ++dv) {
        const LAS unsigned char* vp = vl + (fq * 4 + (fr >> 2)) * 160 + (dv * 16 + 4 * (fr & 3)) * 2;
        const s16x4 lo = vtr(vp), hi = vtr(vp + 16 * 160);
        const bf16x8 a = __builtin_shufflevector(lo, hi, 0, 1, 2, 3, 4, 5, 6, 7);
        o[dv] = MFMA16(a, pb, o[dv]);
    }
}

__device__ __forceinline__ void attn_win_unit(const Ctx& cx, bf16_t* PROJ, int seqbase, int S, int P0, int head, LAS unsigned char* st, LAS unsigned char* vl0) {
    const int lane = cx.tid & 63, wid = __builtin_amdgcn_readfirstlane(cx.tid >> 6), fr = lane & 15, fq = lane >> 4;
    const bf16_t* Kbase = PROJ + (size_t)seqbase * LDP + 512 + head * 64;
    const bf16_t* Vbase = PROJ + (size_t)seqbase * LDP + 1024 + head * 64;
    LAS unsigned char* vl1 = vl0 + 5120;
#pragma unroll 1
    for (int br = 0; br < 3; ++br) {
        const int d = br == 0 ? 1 : (br == 1 ? 4 : 16), W = 64 * d;
        const unsigned koff = (unsigned)(d * fr * LDP + fq * 8) * 2u, voffs = (unsigned)(d * (lane >> 3) * LDP + (lane & 7) * 8) * 2u;
        int pq[2], kb0[2]; bf16_t* qrow[2]; LAS unsigned char* sq[2]; bf16x8 qf[2][2]; float mrun[2], lrun[2]; f32x4 o[2][4];
#pragma unroll
        for (int gi = 0; gi < 2; ++gi) {
            const int idx = 2 * wid + gi;
            const int q0 = br == 0 ? 16 * idx : (br == 1 ? (idx >> 2) + 64 * (idx & 3) : idx);
            const int qrel = q0 + d * fr; pq[gi] = P0 + qrel; kb0[gi] = P0 + q0 - W;
            qrow[gi] = PROJ + (size_t)(seqbase + pq[gi]) * LDP + head * 64;
            qf[gi][0] = *(const bf16x8*)(qrow[gi] + fq * 8); qf[gi][1] = *(const bf16x8*)(qrow[gi] + 32 + fq * 8);
            sq[gi] = st + qrel * 272;
            if (br == 0) { mrun[gi] = -1e30f; lrun[gi] = 0.f;
#pragma unroll
                for (int dv = 0; dv < 4; ++dv) o[gi][dv] = (f32x4){0.f, 0.f, 0.f, 0.f};
            } else { mrun[gi] = *(const LAS float*)(sq[gi] + 256); lrun[gi] = fq == 0 ? *(const LAS float*)(sq[gi] + 260) : 0.f;
#pragma unroll
                for (int dv = 0; dv < 4; ++dv) o[gi][dv] = *(const LAS f32x4*)(sq[gi] + (dv * 16 + fq * 4) * 4); }
        }
        const bool interior = kb0[0] >= 0 && kb0[0] + 159 * d < S && kb0[1] >= 0 && kb0[1] + 159 * d < S;
#define WIN_PAIR(MD, STP) do { bf16x8 kfa_[2][2], kfb_[2][2]; u32x4 vva_[4], vvb_[4]; \
            win_load<(MD) == 0 ? 0 : 1>(Kbase, Vbase, S, d, kb0[0] + d * ((STP) * 32), koff, voffs, lane, kfa_, vva_); \
            win_load<(MD) == 0 ? 0 : 1>(Kbase, Vbase, S, d, kb0[1] + d * ((STP) * 32), koff, voffs, lane, kfb_, vvb_); \
            win_compute<MD>(S, d, W, kb0[0] + d * ((STP) * 32), pq[0], (STP) * 32, kfa_, vva_, qf[0], vl0, lane, mrun[0], lrun[0], o[0]); \
            win_compute<MD>(S, d, W, kb0[1] + d * ((STP) * 32), pq[1], (STP) * 32, kfb_, vvb_, qf[1], vl1, lane, mrun[1], lrun[1], o[1]); } while (0)
        if (interior) {
            WIN_PAIR(2, 0);
#pragma unroll 1
            for (int stp = 1; stp < 4; ++stp) WIN_PAIR(1, stp);
            WIN_PAIR(3, 4);
        } else {
#pragma unroll 1
            for (int stp = 0; stp < 5; ++stp) {
                const int ka_ = kb0[0] + d * (stp * 32), kc_ = kb0[1] + d * (stp * 32);
                const int lo_ = ka_ < kc_ ? ka_ : kc_, hi_ = (ka_ < kc_ ? kc_ : ka_) + 31 * d;
                if (hi_ < 0 || lo_ >= S) continue;
                WIN_PAIR(0, stp);
            }
        }
#undef WIN_PAIR
#pragma unroll
        for (int gi = 0; gi < 2; ++gi) {
            float lt = lrun[gi]; lt += shx(lt, 16, lane); lt += shx(lt, 32, lane);
            if (br < 2) {
#pragma unroll
                for (int dv = 0; dv < 4; ++dv) *(LAS f32x4*)(sq[gi] + (dv * 16 + fq * 4) * 4) = o[gi][dv];
                if (fq == 0) { *(LAS float*)(sq[gi] + 256) = mrun[gi]; *(LAS float*)(sq[gi] + 260) = lt; }
            } else {
                const float inv = 1.0f / lt;
#pragma unroll
                for (int dv = 0; dv < 4; ++dv) { u32x2 w; w.x = cvtpk(o[gi][dv][0] * inv, o[gi][dv][1] * inv); w.y = cvtpk(o[gi][dv][2] * inv, o[gi][dv][3] * inv); *(u32x2*)(qrow[gi] + dv * 16 + fq * 4) = w; }
            }
        }
        __syncthreads();
    }
}

__device__ __forceinline__ void attn_ab(const Ctx& cx, PP p, int part) {
    bf16_t* PROJ = (bf16_t*)(p->ws + OFF_RA); bf16_t* QKVB = (bf16_t*)(p->ws + OFF_RB);
    const int b = cx.bid, G = cx.nb;
    const int wid_s = __builtin_amdgcn_readfirstlane(cx.tid >> 6);
    if (part != 2) for (int u = b; u < 1536; u += G) {
        int seq, head, qb;
        if (u < 1024) { const int i = u >> 8, bb = u & 255; seq = 4 + i; head = bb & 7; qb = bb >> 3; }
        else { const int v = u - 1024, i = v >> 8, bb = v & 255; head = bb & 7; seq = 2 * i + ((bb >> 3) >> 4); qb = (bb >> 3) & 15; }
        const int seqbase = seq < 4 ? seq * 4096 : TP + (seq - 4) * 8192, S = seq < 4 ? 4096 : 8192;
        const int tok0 = seqbase + qb * 256;
        int lu_; asm volatile("v_mbcnt_lo_u32_b32 %0, -1, 0\n\tv_mbcnt_hi_u32_b32 %0, -1, %0" : "=v"(lu_));
        Ctx cxu = cx; cxu.tid = wid_s * 64 + lu_;
        attn_mla(cxu, QKVB + (size_t)tok0 * LDP + head * 256, QKVB + (size_t)seqbase * LDP + head * 256 + 96, QKVB + (size_t)seqbase * LDP + head * 256 + 192, S,
                 PROJ + (size_t)tok0 * LDP + 1536 + head * 64);
    }
    int la_; asm volatile("v_mbcnt_lo_u32_b32 %0, -1, 0\n\tv_mbcnt_hi_u32_b32 %0, -1, %0" : "=v"(la_));
    Ctx cxa = cx; cxa.tid = wid_s * 64 + la_;
    const int wid = wid_s;
    LAS unsigned char* stt = (LAS unsigned char*)smem;
    LAS unsigned char* vl = (LAS unsigned char*)smem + 69632 + wid * 10240;
    if (part != 1) for (int u = b; u < (T / 256) * 8; u += G) {
        const int head = u & 7, blk = u >> 3; const int tok0 = blk * 256;
        int seqbase, S; seq_of_tok(tok0, seqbase, S);
        attn_win_unit(cxa, PROJ, seqbase, S, tok0 - seqbase, head, stt, vl);
    }
}

__device__ __forceinline__ void attn_mem(const Ctx& cx, PP p, int l) {
    constexpr int KSTR = 272, VSTR = 288, KBUF = 256 * KSTR;
    static_assert(KBUF + 256 * VSTR <= LDS_BYTES, "LDS");
    bf16_t* QM = (bf16_t*)(p->ws + OFF_RA); const bf16_t* KVM = (const bf16_t*)(p->ws + OFF_KVM);
    const float* qgain = p->in[21] + l * 128; const float* kgain = p->in[22] + l * 128; const float qscale = 0.08838834764831845f * LOG2E;
    const int b = cx.bid, G = cx.nb, tid = cx.tid, wid = tid >> 6, lane = tid & 63, fr = lane & 15, fq = lane >> 4;
    LAS unsigned char* lds = (LAS unsigned char*)smem;
    const int nunits = (T / 256) * 4, per = (nunits + G - 1) / G;
    int curg = -1;
    for (int j = 0; j < per; ++j) {
        const int u = b * per + j; if (u >= nunits) break;
        int g, qb, seq;
        if (u < 512) { g = u >> 5; qb = u & 31; seq = 4 + (g >> 2); } else { const int v = u - 512; g = 16 + (v >> 4); qb = v & 15; seq = (g - 16) >> 2; }
        const int head = g & 3, seqbase = seq < 4 ? seq * 4096 : TP + (seq - 4) * 8192, tok0 = seqbase + qb * 256, mrow0 = seq * 256;
        if (g != curg) {
            __syncthreads();
            const bf16_t* Kb = KVM + (size_t)mrow0 * 1024 + head * 128; const bf16_t* Vb = Kb + 512;
#pragma unroll
            for (int i = 0; i < 8; ++i) { const int c = tid + i * 512, row = c >> 4, cc = c & 15;
                const u32x4 kv = *(const u32x4*)(Kb + (size_t)row * 1024 + cc * 8), vv = *(const u32x4*)(Vb + (size_t)row * 1024 + cc * 8);
                float kf_[8]; unpack8(kv, kf_); float ks_ = 0.f;
#pragma unroll
                for (int e = 0; e < 8; ++e) ks_ += kf_[e] * kf_[e];
                ks_ = sum16(ks_);
                const float krs_ = rsqrtf(ks_ * (1.0f / 128.0f) + EPS);
#pragma unroll
                for (int e = 0; e < 8; ++e) kf_[e] = kf_[e] * krs_ * kgain[cc * 8 + e];
                *(LAS u32x4*)(lds + row * KSTR + cc * 16) = pack8(kf_); *(LAS u32x4*)(lds + KBUF + row * VSTR + cc * 16) = vv; }
            __syncthreads();
            curg = g;
        }
        bf16_t* Q = QM + (size_t)tok0 * 512 + head * 128;
        bf16x8 qf[2][4];
#pragma unroll
        for (int qg = 0; qg < 2; ++qg) {
            const bf16_t* qp = Q + (size_t)(wid * 32 + qg * 16 + fr) * 512;
            float f[4][8]; float ss = 0.f;
#pragma unroll
            for (int kc = 0; kc < 4; ++kc) { unpack8(*(const u32x4*)(qp + kc * 32 + fq * 8), f[kc]);
#pragma unroll
                for (int i = 0; i < 8; ++i) ss += f[kc][i] * f[kc][i]; }
            ss += shx(ss, 16, lane); ss += shx(ss, 32, lane);
            const float rs = rsqrtf(ss * (1.0f / 128.0f) + EPS) * qscale;
#pragma unroll
            for (int kc = 0; kc < 4; ++kc) {
#pragma unroll
                for (int i = 0; i < 8; ++i) f[kc][i] = f[kc][i] * rs * qgain[kc * 32 + fq * 8 + i];
                qf[qg][kc] = __builtin_bit_cast(bf16x8, pack8(f[kc])); }
        }
        float mrun[2], lrun[2]; f32x4 o[2][8];
#pragma unroll
        for (int qg = 0; qg < 2; ++qg) { mrun[qg] = -1e30f; lrun[qg] = 0.f;
#pragma unroll
            for (int d = 0; d < 8; ++d) o[qg][d] = (f32x4){0.f, 0.f, 0.f, 0.f}; }
#pragma unroll 1
        for (int sub = 0; sub < 4; ++sub) {
            const LAS unsigned char* Kl = lds + sub * 64 * KSTR; const LAS unsigned char* Vl = lds + KBUF + sub * 64 * VSTR;
            f32x4 s[2][4];
#pragma unroll
            for (int qg = 0; qg < 2; ++qg)
#pragma unroll
                for (int kt = 0; kt < 4; ++kt) s[qg][kt] = (f32x4){0.f, 0.f, 0.f, 0.f};
#pragma unroll
            for (int kt = 0; kt < 4; ++kt)
#pragma unroll
                for (int kc = 0; kc < 4; ++kc) { const bf16x8 a = *(const LAS bf16x8*)(Kl + (kt * 16 + fr) * KSTR + (kc * 32 + fq * 8) * 2);
#pragma unroll
                    for (int qg = 0; qg < 2; ++qg) s[qg][kt] = MFMA16(a, qf[qg][kc], s[qg][kt]); }
            bf16x8 pb[2][2];
#pragma unroll
            for (int qg = 0; qg < 2; ++qg) {
                float mx = s[qg][0][0];
#pragma unroll
                for (int kt = 0; kt < 4; ++kt)
#pragma unroll
                    for (int jj = 0; jj < 4; ++jj) mx = fmaxf(mx, s[qg][kt][jj]);
                mx = fmaxf(mx, shx(mx, 16, lane)); mx = fmaxf(mx, shx(mx, 32, lane));
                const float mn = fmaxf(mrun[qg], mx), alpha = __builtin_amdgcn_exp2f(mrun[qg] - mn); mrun[qg] = mn;
                float rsum = 0.f;
#pragma unroll
                for (int kt = 0; kt < 4; ++kt)
#pragma unroll
                    for (int jj = 0; jj < 4; ++jj) { const float pv = __builtin_amdgcn_exp2f(s[qg][kt][jj] - mn); s[qg][kt][jj] = pv; rsum += pv; }
                lrun[qg] = lrun[qg] * alpha + rsum;
#pragma unroll
                for (int d = 0; d < 8; ++d) o[qg][d] = o[qg][d] * alpha;
#pragma unroll
                for (int t2 = 0; t2 < 2; ++t2) { u32x4 w; w.x = cvtpk(s[qg][2 * t2][0], s[qg][2 * t2][1]); w.y = cvtpk(s[qg][2 * t2][2], s[qg][2 * t2][3]);
                    w.z = cvtpk(s[qg][2 * t2 + 1][0], s[qg][2 * t2 + 1][1]); w.w = cvtpk(s[qg][2 * t2 + 1][2], s[qg][2 * t2 + 1][3]); pb[qg][t2] = __builtin_bit_cast(bf16x8, w); }
            }
#pragma unroll
            for (int t2 = 0; t2 < 2; ++t2)
#pragma unroll
                for (int d = 0; d < 8; ++d) {
                    const LAS unsigned char* vp = Vl + (t2 * 32 + fq * 4 + (fr >> 2)) * VSTR + (d * 16 + 4 * (fr & 3)) * 2;
                    const s16x4 lo = vtr(vp), hi = vtr(vp + 16 * VSTR);
                    const bf16x8 a = __builtin_shufflevector(lo, hi, 0, 1, 2, 3, 4, 5, 6, 7);
#pragma unroll
                    for (int qg = 0; qg < 2; ++qg) o[qg][d] = MFMA16(a, pb[qg][t2], o[qg][d]);
                }
        }
#pragma unroll
        for (int qg = 0; qg < 2; ++qg) {
            float lt = lrun[qg]; lt += shx(lt, 16, lane); lt += shx(lt, 32, lane);
            const float inv = 1.0f / lt;
            bf16_t* op = Q + (size_t)(wid * 32 + qg * 16 + fr) * 512 + fq * 4;
#pragma unroll
            for (int d = 0; d < 8; ++d) { u32x2 w; w.x = cvtpk(o[qg][d][0] * inv, o[qg][d][1] * inv); w.y = cvtpk(o[qg][d][2] * inv, o[qg][d][3] * inv); *(u32x2*)(op + d * 16) = w; }
        }
    }
}

__device__ __forceinline__ g8::GemmDesc mk_bf16(const bf16_t* A, int lda, const bf16_t* Bt, int ldb, int M, int N, int K, bf16_t* O, int ldc, int relu2, const float* ss = nullptr, int ssrow0 = 0) {
    g8::GemmDesc d; d.A = A; d.Bt = Bt; d.lda = lda; d.ldb = ldb; d.M = M; d.N = N; d.K = K; d.rev = 0; d.epi.mode = relu2; d.epi.eb = g8::EpiBf16{O, ldc, relu2, ss, ssrow0}; d.epi.er = g8::EpiRes{nullptr, nullptr, 0, nullptr, 0, nullptr, nullptr}; return d; }
__device__ __forceinline__ g8::GemmDesc mk_res(const bf16_t* A, int lda, const bf16_t* Bt, int ldb, int M, int N, int K, const float* x0, const float* x1, int split, float* out, int rowoff, bf16_t* xb, float* ss) {
    g8::GemmDesc d; d.A = A; d.Bt = Bt; d.lda = lda; d.ldb = ldb; d.M = M; d.N = N; d.K = K; d.rev = 0; d.epi.mode = 2; d.epi.eb = g8::EpiBf16{nullptr, 0, 0, nullptr, 0}; d.epi.er = g8::EpiRes{x0, x1, split, out, rowoff, xb, ss}; return d; }

#define FRESH_CX Ctx cx = cx0; { int l__; asm volatile("v_mbcnt_lo_u32_b32 %0, -1, 0\n\tv_mbcnt_hi_u32_b32 %0, -1, %0" : "=v"(l__)); cx.tid = wid_sg * 64 + l__; }
__device__ __forceinline__ void run_phase(const Ctx& cx0, PP p, int ph) {
    const int l = ph / NPH_LAYER; int q = ph % NPH_LAYER;
    const int wid_sg = cx0.tid;
#ifdef SPLIT_AB
    q = q <= 5 ? q : (q == 6 ? 19 : q - 1);
#endif
    bf16_t* W = (bf16_t*)(p->ws + OFF_W) + (size_t)l * W_LAYER_E;
    bf16_t* RA = (bf16_t*)(p->ws + OFF_RA); bf16_t* RB = (bf16_t*)(p->ws + OFF_RB);
    bf16_t* MM = (bf16_t*)(p->ws + OFF_MM); bf16_t* KVM = (bf16_t*)(p->ws + OFF_KVM);
    const float* x0 = l == 0 ? p->in[0] : p->out; const float* x1 = l == 0 ? p->in[1] : p->out + (size_t)TP * 1024;
    float* SS = (float*)(p->ws + OFF_SS);
    int ng = 0; g8::GemmDesc d0 = mk_bf16(nullptr, 0, nullptr, 0, 0, 0, 0, nullptr, 0, 0), d1 = d0;
    switch (q) {
    case 0: {  FRESH_CX;
        prologue(cx, p);
        xcast_rows(cx, p->in[0], p->in[1], TP, RB, SS, T);
        norm_rows(cx, p->in[2], p->in[3], 1024, p->in[18], MM, NMEMTOK);
        norm_rows(cx, p->in[2], p->in[3], 1024, p->in[18] + 1024, MM + (size_t)NMEMTOK * 1024, NMEMTOK);
        } break;
    case 1: ng = 1; d0 = mk_bf16(RB, 1024, W + WO_IN, 1024, T, 2048, 1024, RA, LDP, 0, SS, 0); break;
    case 2: { FRESH_CX; prep_a(cx, p, l); } break;
    case 3: ng = 1; d0 = mk_bf16(RA + 1536, LDP, W + WO_QKV, 384, T, 2048, 384, RB, LDP, 0); break;
    case 4: { FRESH_CX; prep_b(cx, p, l); } break;
#ifdef SPLIT_AB
    case 5: { FRESH_CX; attn_ab(cx, p, 1); } break;
    case 19: { FRESH_CX; attn_ab(cx, p, 2); } break;
#else
    case 5: { FRESH_CX; attn_ab(cx, p, 0); } break;
#endif
    case 6: { FRESH_CX; out_norm(cx, p, l); } break;
    case 7: ng = 1; d0 = mk_res(RA, LDP, W + WO_OUT, 1024, T, 1024, 1024, x0, x1, TP, p->out, 0, RB, SS); break;
    case 9: ng = 2; d0 = mk_bf16(RB, 1024, W + WO_MQ, 1024, T, 512, 1024, RA, 512, 0, SS, 0);
            d1 = mk_bf16(MM + (size_t)l * NMEMTOK * 1024, 1024, W + WO_MKV, 1024, NMEMTOK, 1024, 1024, KVM, 1024, 0); d1.rev = 1; break;
    case 10: { FRESH_CX; attn_mem(cx, p, l); } break;
    case 11: ng = 1; d0 = mk_res(RA, 512, W + WO_MO, 512, T, 1024, 512, p->out, p->out, T, p->out, 0, RB, SS); break;
    case 8: case 12: break;
    default: {
        const int c = (q - 13) >> 1, rowoff = c * 16384; ng = 1;
        if (((q - 13) & 1) == 0) d0 = mk_bf16(RB + (size_t)rowoff * 1024, 1024, W + WO_1, 1024, 16384, 4096, 1024, RA, 4096, 1, SS, rowoff);
        else d0 = mk_res(RA, 4096, W + WO_2, 4096, 16384, 1024, 4096, p->out, p->out, T, p->out, rowoff, RB, SS);
    } break;
    }
    int lg_; asm volatile("v_mbcnt_lo_u32_b32 %0, -1, 0\n\tv_mbcnt_hi_u32_b32 %0, -1, %0" : "=v"(lg_));
    Ctx cxg = cx0; cxg.tid = wid_sg * 64 + lg_;
#pragma unroll 1
    for (int gi = 0; gi < ng; ++gi) { const g8::GemmDesc d = gi == 0 ? d0 : d1; g8::gemm_phase(cxg, d.A, d.lda, d.Bt, d.ldb, d.M, d.N, d.K, d.epi, d.rev); }
}

__device__ __forceinline__ void grid_bar(unsigned* ctr, unsigned target, bool leader) {
    asm volatile("s_waitcnt vmcnt(0)" ::: "memory");
    __syncthreads();
    if (leader) {
        __builtin_amdgcn_fence(__ATOMIC_RELEASE, "agent");
        asm volatile("s_waitcnt vmcnt(0)" ::: "memory");
        (void)__hip_atomic_fetch_add(ctr, 1u, __ATOMIC_RELAXED, __HIP_MEMORY_SCOPE_AGENT);
        unsigned spins = 0;
        while (__hip_atomic_load(ctr, __ATOMIC_RELAXED, __HIP_MEMORY_SCOPE_AGENT) < target) { __builtin_amdgcn_s_sleep(1); if (++spins > (1u << 22)) break; }
        __builtin_amdgcn_fence(__ATOMIC_ACQUIRE, "agent");
        asm volatile("s_waitcnt vmcnt(0)" ::: "memory");
    }
    __syncthreads();
}

#define XB_TMO      128
#define XB_XCNT(j)  (256  + 64 * (j))
#define XB_XSUB(j)  (1280 + 64 * (j))
#define XB_XGEN(j)  (2304 + 64 * (j))
#define XB_TOP      3328
#define XB_TOPGEN   3392
#define XB_SPIN_CAP (1u << 20)
__device__ __forceinline__ unsigned xb_ld(unsigned* p)              { return __hip_atomic_load(p, __ATOMIC_RELAXED, __HIP_MEMORY_SCOPE_AGENT); }
__device__ __forceinline__ unsigned xb_add(unsigned* p, unsigned v) { return __hip_atomic_fetch_add(p, v, __ATOMIC_RELAXED, __HIP_MEMORY_SCOPE_AGENT); }
__device__ __forceinline__ unsigned xb_xcc_id() { return (unsigned)__builtin_amdgcn_s_getreg((3 << 11) | 20) & 0xFu; }
#define XB_SPIN(cond, bar) do { unsigned _sp = 0; while (cond) { __builtin_amdgcn_s_sleep(1); \
    if ((++_sp & 255u) == 0u) { if (xb_ld(&(bar)[XB_TMO])) break; if (_sp > XB_SPIN_CAP) { atomicAdd(&(bar)[XB_TMO], 1u); break; } } } } while (0)
__device__ __forceinline__ void xcd_bar(unsigned* bar, volatile LAS unsigned* st, bool leader, unsigned G) {
    asm volatile("s_waitcnt vmcnt(0)" ::: "memory");
    __syncthreads();
    if (leader) {
        const unsigned x = xb_xcc_id();
        __builtin_amdgcn_s_waitcnt(0);
        unsigned nloc = st[0], nx = st[1];
        if (nloc == 0u) {
            unsigned sum, cnt, mine, sp = 0u;
            for (;;) {
                sum = 0u; cnt = 0u; mine = 0u;
#pragma unroll
                for (unsigned j = 0; j < 16; ++j) { const unsigned c = xb_ld(&bar[XB_XCNT(j)]); sum += c; cnt += (c > 0u) ? 1u : 0u; mine = (j == x) ? c : mine; }
                if (sum == G) break;
                __builtin_amdgcn_s_sleep(1);
                if ((++sp & 255u) == 0u) { if (xb_ld(&bar[XB_TMO])) break; if (sp > XB_SPIN_CAP) { atomicAdd(&bar[XB_TMO], 1u); break; } }
            }
            nloc = mine > 0u ? mine : 1u; nx = cnt > 0u ? cnt : 1u; st[0] = nloc; st[1] = nx;
        }
        const unsigned old = xb_add(&bar[XB_XSUB(x)], 1u);
        const unsigned gen = old / nloc;
        if (old + 1u == (gen + 1u) * nloc) {
            __builtin_amdgcn_fence(__ATOMIC_RELEASE, "agent");
            asm volatile("s_waitcnt vmcnt(0)" ::: "memory");
            const unsigned og = xb_add(&bar[XB_TOP], 1u);
            const unsigned tg = og / nx;
            if (og + 1u == (tg + 1u) * nx) xb_add(&bar[XB_TOPGEN], 1u);
            else XB_SPIN(xb_ld(&bar[XB_TOPGEN]) == tg, bar);
            __builtin_amdgcn_fence(__ATOMIC_ACQUIRE, "agent");
            xb_add(&bar[XB_XGEN(x)], 1u);
            asm volatile("s_waitcnt vmcnt(0)" ::: "memory");
        } else {
            XB_SPIN(xb_ld(&bar[XB_XGEN(x)]) == gen, bar);
            __builtin_amdgcn_fence(__ATOMIC_ACQUIRE, "agent");
            asm volatile("s_waitcnt vmcnt(0)" ::: "memory");
        }
    }
    __syncthreads();
}

#ifndef PROBE_MULT
#define PROBE_MULT 0
#endif
#ifndef PROBE_MASK
#define PROBE_MASK 0
#endif
__global__ void __launch_bounds__(512) mega_fwd(Params pv) {
    cg::grid_group grid = cg::this_grid();
    const int ph_lo = pv.ph_lo, ph_hi = pv.ph_hi;
    int wid_s = __builtin_amdgcn_readfirstlane(threadIdx.x >> 6);
    unsigned long long t0 = 0, tacc = 0;
    unsigned nbar = 0;
    bool did_cg = false;
    volatile LAS unsigned* xst = (volatile LAS unsigned*)((LAS unsigned char*)smem + LDS_BYTES - 16);
    { int l0_; asm volatile("v_mbcnt_lo_u32_b32 %0, -1, 0\n\tv_mbcnt_hi_u32_b32 %0, -1, %0" : "=v"(l0_));
      if (wid_s == 0 && l0_ == 0) { xst[0] = 0u; xst[1] = 0u; (void)xb_add(&((unsigned*)(pv.ws + OFF_BAR))[XB_XCNT(xb_xcc_id())], 1u); }
      __syncthreads(); }
    for (int ph = ph_lo; ph < ph_hi; ++ph) {
        { const int qq = ph % NPH_LAYER; if (qq == 8 || qq == 12 || (qq == 0 && ph >= NPH_LAYER)) continue; }
        Ctx cx; cx.bid = blockIdx.x; cx.nb = gridDim.x;
        asm volatile("" : "+s"(wid_s));
        cx.tid = wid_s;
        asm volatile("" : "+s"(cx.bid)); asm volatile("" : "+s"(cx.nb));
        auto ka = __builtin_amdgcn_kernarg_segment_ptr();
        asm volatile("" : "+s"(ka));
        if (PROBE_MULT > 0 && ((PROBE_MASK >> (ph % NPH_LAYER)) & 1)) t0 = __builtin_amdgcn_s_memrealtime();
        run_phase(cx, (PP)ka, ph);
        if (ph + 1 < ph_hi) {
            if (!did_cg && ph_hi > 100000) { grid.sync(); did_cg = true; }
            else { ++nbar; int lane_; asm volatile("v_mbcnt_lo_u32_b32 %0, -1, 0\n\tv_mbcnt_hi_u32_b32 %0, -1, %0" : "=v"(lane_));
                   xcd_bar((unsigned*)(((PP)ka)->ws + OFF_BAR), xst, wid_s == 0 && lane_ == 0, (unsigned)cx.nb); }
        }
        if (PROBE_MULT > 0 && ((PROBE_MASK >> (ph % NPH_LAYER)) & 1)) tacc += __builtin_amdgcn_s_memrealtime() - t0;
    }
    if (PROBE_MULT > 0 && blockIdx.x == 0) {
        const unsigned long long te = __builtin_amdgcn_s_memrealtime();
        while (__builtin_amdgcn_s_memrealtime() - te < tacc * PROBE_MULT) __builtin_amdgcn_s_sleep(8);
    }
}

extern "C" void kernel_launch(void* const* d_in, const int* in_sizes, int n_in, void* d_out, int out_size, void* d_ws, size_t ws_size, hipStream_t stream) {
    static int grid = 0;
    if (grid == 0) {
        if (n_in != 27 || ws_size < WS_END) { fprintf(stderr, "kernel_launch: unexpected n_in %d / ws_size %zu (need %zu)\n", n_in, ws_size, (size_t)WS_END); grid = -1; return; }
        if (hipFuncSetAttribute((const void*)mega_fwd, hipFuncAttributeMaxDynamicSharedMemorySize, LDS_BYTES) != hipSuccess) { fprintf(stderr, "kernel_launch: hipFuncSetAttribute failed\n"); grid = -1; return; }
        int dev = 0, cus = 0, per_cu = 0;
        hipGetDevice(&dev); hipDeviceGetAttribute(&cus, hipDeviceAttributeMultiprocessorCount, dev);
        hipOccupancyMaxActiveBlocksPerMultiprocessor(&per_cu, (const void*)mega_fwd, 512, LDS_BYTES);
        (void)hipGetLastError();
        if (per_cu < 1) per_cu = 1;
        grid = cus * per_cu; if (grid > 256) grid = 256; grid &= ~7;
        if (grid < 8) grid = 8;
    }
    if (grid < 0) return;
    if (hipMemsetAsync((unsigned char*)d_ws + OFF_BAR, 0, 16384, stream) != hipSuccess) { fprintf(stderr, "kernel_launch: memset of the barrier words failed\n"); return; }
    Params p{};
    for (int i = 0; i < 27; ++i) p.in[i] = (const float*)d_in[i];
    p.out = (float*)d_out; p.ws = (unsigned char*)d_ws;
#if MK_ONE_LAUNCH
    p.ph_lo = 0; p.ph_hi = NPH;
    void* args[] = {&p};
    hipError_t e = hipLaunchCooperativeKernel((const void*)mega_fwd, dim3(grid), dim3(512), args, LDS_BYTES, stream);
    if (e != hipSuccess) fprintf(stderr, "cooperative launch failed: %s (grid %d)\n", hipGetErrorString(e), grid);
#else
    for (int ph = 0; ph < NPH; ++ph) { p.ph_lo = ph; p.ph_hi = ph + 1; hipLaunchKernelGGL(mega_fwd, dim3(grid), dim3(512), LDS_BYTES, stream, p); }
#endif
}
```

```cpp
#include <hip/hip_runtime.h>
#include <hip/hip_cooperative_groups.h>
#include <cstdio>
#include <cstdint>
namespace cg = cooperative_groups;

#ifndef MK_ONE_LAUNCH
#define MK_ONE_LAUNCH 1
#endif

typedef unsigned short bf16_t;
typedef short bf16x8 __attribute__((ext_vector_type(8)));
typedef short s16x4 __attribute__((ext_vector_type(4)));
typedef float f32x4 __attribute__((ext_vector_type(4)));
typedef unsigned u32x4 __attribute__((ext_vector_type(4)));
typedef unsigned u32x2 __attribute__((ext_vector_type(2)));
typedef short v4i16_t __attribute__((ext_vector_type(4)));
#define LAS __attribute__((address_space(3)))

constexpr int T = 49152, TP = 16384, NMEMTOK = 2048;
constexpr int LDP = 2048;
#ifdef SPLIT_AB
constexpr int NPH_LAYER = 20, NPH = 2 * NPH_LAYER;
#else
constexpr int NPH_LAYER = 19, NPH = 2 * NPH_LAYER;
#endif
constexpr float EPS = 1e-6f;
constexpr float LOG2E = 1.4426950408889634f;

constexpr size_t W_IN_E = 2048ull * 1024, W_QKV_E = 2048ull * 384, W_OUT_E = 1024ull * 1024, W_MQ_E = 512ull * 1024,
                 W_MKV_E = 1024ull * 1024, W_MO_E = 1024ull * 512, W_1_E = 4096ull * 1024, W_2_E = 1024ull * 4096;
constexpr size_t WO_IN = 0, WO_QKV = WO_IN + W_IN_E, WO_OUT = WO_QKV + W_QKV_E, WO_MQ = WO_OUT + W_OUT_E, WO_MKV = WO_MQ + W_MQ_E,
                 WO_MO = WO_MKV + W_MKV_E, WO_1 = WO_MO + W_MO_E, WO_2 = WO_1 + W_1_E, W_LAYER_E = WO_2 + W_2_E;
constexpr size_t OFF_W = 0, OFF_CS = OFF_W + 2 * W_LAYER_E * 2, OFF_MM = OFF_CS + 8192ull * 16 * 8, OFF_KVM = OFF_MM + 2 * 2048ull * 1024 * 2,
                 OFF_RA = OFF_KVM + 2048ull * 1024 * 2, OFF_RB = OFF_RA + (size_t)T * 2048 * 2, OFF_BAR = OFF_RB + (size_t)T * 2048 * 2, OFF_SS = OFF_BAR + 16384, WS_END = OFF_SS + (size_t)T * 16 * 4;
constexpr int LDS_BYTES = 155648;

struct Params { const float* in[27]; float* out; unsigned char* ws; int ph_lo, ph_hi; };

extern __shared__ __attribute__((aligned(16))) unsigned char smem[];
typedef const __attribute__((address_space(4))) Params* PP;
struct Ctx { int tid, bid, nb; };

typedef float f32x2_t __attribute__((ext_vector_type(2)));
typedef __bf16 bf16x2_t __attribute__((ext_vector_type(2)));
__device__ __forceinline__ unsigned cvtpk(float lo, float hi) { const f32x2_t v = {lo, hi}; return __builtin_bit_cast(unsigned, __builtin_convertvector(v, bf16x2_t)); }
__device__ __forceinline__ float bflo(unsigned u) { return __uint_as_float(u << 16); }
__device__ __forceinline__ float bfhi(unsigned u) { return __uint_as_float(u & 0xffff0000u); }
__device__ __forceinline__ void unpack8(const u32x4 v, float* f) {
#pragma unroll
    for (int i = 0; i < 4; ++i) { f[2 * i] = bflo(v[i]); f[2 * i + 1] = bfhi(v[i]); } }
__device__ __forceinline__ u32x4 pack8(const float* f) { u32x4 r; r.x = cvtpk(f[0], f[1]); r.y = cvtpk(f[2], f[3]); r.z = cvtpk(f[4], f[5]); r.w = cvtpk(f[6], f[7]); return r; }
__device__ __forceinline__ float shx(float v, int m, int lane) { return __int_as_float(__builtin_amdgcn_ds_bpermute((lane ^ m) << 2, __float_as_int(v))); }
__device__ __forceinline__ float shl(float v, int src) { return __int_as_float(__builtin_amdgcn_ds_bpermute(src << 2, __float_as_int(v))); }
__device__ __forceinline__ float wave_sum(float v, int lane) {
#pragma unroll
    for (int o = 32; o >= 1; o >>= 1) v += shx(v, o, lane);
    return v; }
template <int CTRL> __device__ __forceinline__ float dppf(float x) { return __builtin_bit_cast(float, __builtin_amdgcn_mov_dpp(__builtin_bit_cast(int, x), CTRL, 0xf, 0xf, true)); }
constexpr int DPP_XOR1 = 0xB1, DPP_XOR2 = 0x4E, DPP_XOR7 = 0x141, DPP_XOR8 = 0x128;
__device__ __forceinline__ float sum8(float v) { v += dppf<DPP_XOR1>(v); v += dppf<DPP_XOR2>(v); v += dppf<DPP_XOR7>(v); return v; }
__device__ __forceinline__ float sum16(float v) { v = sum8(v); v += dppf<DPP_XOR8>(v); return v; }
__device__ __forceinline__ float sum64(float v, int lane) { v = sum16(v); v += shx(v, 16, lane); v += shx(v, 32, lane); return v; }
__device__ __forceinline__ void seq_of_tok(int tok, int& seqbase, int& S) {
    if (tok < TP) { seqbase = tok & ~4095; S = 4096; } else { seqbase = TP + ((tok - TP) & ~8191); S = 8192; } }

namespace g8 {
constexpr int BM = 256, BK = 64, HALF = 128, HT = HALF * BK;
__device__ __forceinline__ int lds_byte(int r, int c) { int st = (r >> 4) * 2 + (c >> 5), rr = r & 15, cc = c & 31, ob = rr * 64 + cc * 2; return st * 1024 + (ob ^ (((ob >> 9) & 1) << 5)); }
__device__ __forceinline__ void stage_rc(int b, int& R, int& C) { int st = b / 1024, sb = b % 1024, swz = sb ^ (((sb >> 9) & 1) << 5); R = (st >> 1) * 16 + swz / 64; C = (st & 1) * 32 + (swz % 64) / 2; }

__device__ __forceinline__ int perm32(int rho) { const int n = rho >> 4, i = rho & 15; return 8 * (i >> 2) + 4 * n + (i & 3); }
struct EpiBf16 { bf16_t* O; int ldc; int relu2; const float* ss; int ssrow0;
    __device__ __forceinline__ void operator()(const f32x4 (&acc)[2][2][4][2], int brow, int bcol, int wr, int wc, int fr, int fq, int lane) const {
#pragma unroll
        for (int ai = 0; ai < 2; ++ai) {
            float rs[4];
            if (ss) {
                f32x4 sv[4][4];
#pragma unroll
                for (int m = 0; m < 4; ++m) { const f32x4* sp = (const f32x4*)(ss + (size_t)(ssrow0 + brow + ai * HALF + wr * 64 + m * 16 + fr) * 16);
#pragma unroll
                    for (int i = 0; i < 4; ++i) sv[m][i] = sp[i]; }
#pragma unroll
                for (int m = 0; m < 4; ++m) { const f32x4 t = (sv[m][0] + sv[m][1]) + (sv[m][2] + sv[m][3]); rs[m] = rsqrtf(((t[0] + t[1]) + (t[2] + t[3])) * (1.0f / 1024.0f) + EPS); }
            } else {
#pragma unroll
                for (int m = 0; m < 4; ++m) rs[m] = 1.0f;
            }
#pragma unroll
            for (int m = 0; m < 4; ++m) { const int rl = brow + ai * HALF + wr * 64 + m * 16 + fr; bf16_t* rp = O + (size_t)rl * ldc + bcol + wc * 32 + fq * 8;
#pragma unroll
                for (int bj = 0; bj < 2; ++bj) { f32x4 v0 = acc[ai][bj][m][0] * rs[m], v1 = acc[ai][bj][m][1] * rs[m];
                    if (relu2) {
#pragma unroll
                        for (int j = 0; j < 4; ++j) { float t = v0[j] > 0.f ? v0[j] : 0.f; v0[j] = t * t; t = v1[j] > 0.f ? v1[j] : 0.f; v1[j] = t * t; } }
                    u32x4 w; w.x = cvtpk(v0[0], v0[1]); w.y = cvtpk(v0[2], v0[3]); w.z = cvtpk(v1[0], v1[1]); w.w = cvtpk(v1[2], v1[3]); *(u32x4*)(rp + bj * HALF) = w; } }
            __builtin_amdgcn_sched_barrier(0);
        } } };
struct EpiRes { const float* x0; const float* x1; int split; float* out; int rowoff; bf16_t* xb; float* ss;
    __device__ __forceinline__ void operator()(const f32x4 (&acc)[2][2][4][2], int brow, int bcol, int wr, int wc, int fr, int fq, int lane) const {
#pragma unroll
        for (int ai = 0; ai < 2; ++ai) {
            f32x4 xv[4][2][2];
#pragma unroll
            for (int m = 0; m < 4; ++m) { const int row = rowoff + brow + ai * HALF + wr * 64 + m * 16 + fr; const int c0 = bcol + wc * 32 + fq * 8;
                const float* xp = (row < split ? x0 + (size_t)row * 1024 : x1 + (size_t)(row - split) * 1024) + c0;
#pragma unroll
                for (int bj = 0; bj < 2; ++bj) { xv[m][bj][0] = *(const f32x4*)(xp + bj * HALF); xv[m][bj][1] = *(const f32x4*)(xp + bj * HALF + 4); } }
            float sq[4];
#pragma unroll
            for (int m = 0; m < 4; ++m) { const int row = rowoff + brow + ai * HALF + wr * 64 + m * 16 + fr; const int c0 = bcol + wc * 32 + fq * 8;
                float* op = out + (size_t)row * 1024 + c0; bf16_t* bp = xb + (size_t)row * 1024 + c0; sq[m] = 0.f;
#pragma unroll
                for (int bj = 0; bj < 2; ++bj) { const f32x4 v0 = xv[m][bj][0] + acc[ai][bj][m][0], v1 = xv[m][bj][1] + acc[ai][bj][m][1];
                    *(f32x4*)(op + bj * HALF) = v0; *(f32x4*)(op + bj * HALF + 4) = v1;
                    u32x4 w; w.x = cvtpk(v0[0], v0[1]); w.y = cvtpk(v0[2], v0[3]); w.z = cvtpk(v1[0], v1[1]); w.w = cvtpk(v1[2], v1[3]); *(u32x4*)(bp + bj * HALF) = w;
                    sq[m] += (v0[0] * v0[0] + v0[1] * v0[1]) + (v0[2] * v0[2] + v0[3] * v0[3]) + (v1[0] * v1[0] + v1[1] * v1[1]) + (v1[2] * v1[2] + v1[3] * v1[3]); } }
#pragma unroll
            for (int m = 0; m < 4; ++m) sq[m] += shx(sq[m], 16, lane);
#pragma unroll
            for (int m = 0; m < 4; ++m) sq[m] += shx(sq[m], 32, lane);
            if (fq == 0) {
#pragma unroll
                for (int m = 0; m < 4; ++m) ss[(size_t)(rowoff + brow + ai * HALF + wr * 64 + m * 16 + fr) * 16 + (bcol >> 8) * 4 + wc] = sq[m]; }
            __builtin_amdgcn_sched_barrier(0); } } };
struct EpiAny { int mode; EpiBf16 eb; EpiRes er;
    __device__ __forceinline__ void operator()(const f32x4 (&acc)[2][2][4][2], int brow, int bcol, int wr, int wc, int fr, int fq, int lane) const {
        if (mode == 2) er(acc, brow, bcol, wr, wc, fr, fq, lane); else eb(acc, brow, bcol, wr, wc, fr, fq, lane); } };
struct GemmDesc { const bf16_t* A; const bf16_t* Bt; int lda, ldb, M, N, K, rev; EpiAny epi; };

template <class Epi>
__device__ __forceinline__ void gemm_phase(const Ctx& cx, const bf16_t* A, int lda, const bf16_t* Bt, int ldb, int M, int N, int K, const Epi& epi, int rev = 0) {
    const int nM = M / BM, nN = N / BM, b = cx.bid, per = (nM >> 3) * nN, step = cx.nb >> 3;
    int w = rev ? (step - 1 - (b >> 3)) : (b >> 3);
    if (w >= per) return;
    unsigned voffA[2], voffB[2];
#pragma unroll
    for (int i = 0; i < 2; ++i) { int R, C; stage_rc(cx.tid * 16 + i * 8192, R, C); voffA[i] = (unsigned)(R * lda + C) * 2u; voffB[i] = (unsigned)(((R & ~31) + perm32(R & 31)) * ldb + C) * 2u; }
    const size_t hstepA = (size_t)HALF * lda * 2, hstepB = (size_t)HALF * ldb * 2;
    LAS unsigned char* lds = (LAS unsigned char*)smem;
    constexpr int HTB = HT * 2;
    constexpr size_t kstep = BK * 2;
    const int nt = K / BK;
#define SA(b, h) (((b) * 2 + (h)) * HTB)
#define SB(b, h) ((4 + (b) * 2 + (h)) * HTB)
#define STAGE(bufoff, gbase, voff) do { _Pragma("unroll") for (int _i = 0; _i < 2; ++_i) \
      __builtin_amdgcn_global_load_lds((const unsigned*)((const char*)(gbase) + (voff)[_i]), (LAS unsigned*)(lds + (bufoff) + ldsw + _i * 8192), 16, 0, 0); } while (0)
#define LDA(dst, b, h) do { _Pragma("unroll") for (int m = 0; m < 4; ++m) _Pragma("unroll") for (int k = 0; k < 2; ++k) dst[m][k] = *(const LAS bf16x8*)(lds + SA(b, h) + aoff + m * 2048 + k * 1024); } while (0)
#define LDB(dst, b, h) do { _Pragma("unroll") for (int n = 0; n < 2; ++n) _Pragma("unroll") for (int k = 0; k < 2; ++k) dst[n][k] = *(const LAS bf16x8*)(lds + SB(b, h) + boff + n * 2048 + k * 1024); } while (0)
#define MMA(ai, bj, At, Bt_) do { __builtin_amdgcn_s_setprio(1); _Pragma("unroll") for (int m = 0; m < 4; ++m) _Pragma("unroll") for (int n = 0; n < 2; ++n) _Pragma("unroll") for (int k = 0; k < 2; ++k) \
      acc[ai][bj][m][n] = __builtin_amdgcn_mfma_f32_16x16x32_bf16(Bt_[n][k], At[m][k], acc[ai][bj][m][n], 0, 0, 0); \
    __builtin_amdgcn_s_setprio(0); } while (0)
#define WAIT_V(n) asm volatile("s_waitcnt vmcnt(" #n ")" ::: "memory")
#define WAIT_L(n) asm volatile("s_waitcnt lgkmcnt(" #n ")" ::: "memory")
#define BAR __builtin_amdgcn_s_barrier()
#define SCHED __builtin_amdgcn_sched_barrier(0)
#define ZACC do { _Pragma("unroll") for (int a_ = 0; a_ < 2; ++a_) _Pragma("unroll") for (int b_ = 0; b_ < 2; ++b_) _Pragma("unroll") for (int m = 0; m < 4; ++m) _Pragma("unroll") for (int n = 0; n < 2; ++n) acc[a_][b_][m][n] = (f32x4){0.f, 0.f, 0.f, 0.f}; } while (0)
    const int wid = __builtin_amdgcn_readfirstlane(cx.tid >> 6), lane = cx.tid & 63, wr = wid >> 2, wc = wid & 3, fr = lane & 15, fq = lane >> 4;
    const unsigned ldsw = (unsigned)wid * 1024u;
    const int aoff = lds_byte(wr * 64 + fr, fq * 8), boff = lds_byte(wc * 32 + fr, fq * 8);
    f32x4 acc[2][2][4][2];
    ZACC;
    bf16x8 At[4][2], B0[2][2], B1[2][2];
    int pm = (b & 7) + 8 * (w / nN), pn = w % nN;
    const char* cA = (const char*)A + (size_t)pm * 2 * hstepA; const char* cB = (const char*)Bt + (size_t)pn * 2 * hstepB;
    STAGE(SB(0, 0), cB, voffB); STAGE(SB(0, 1), cB + hstepB, voffB); STAGE(SA(0, 0), cA, voffA); STAGE(SA(0, 1), cA + hstepA, voffA);
    if (wr == 1) BAR;
    WAIT_V(2); BAR;
    STAGE(SB(1, 0), cB + kstep, voffB); STAGE(SA(1, 0), cA + kstep, voffA); STAGE(SB(1, 1), cB + hstepB + kstep, voffB);
    WAIT_V(6); BAR;
    for (;;) {
        const int wn = w + step; const bool has_next = wn < per;
        const int pmn = (b & 7) + 8 * (wn / nN), pnn = wn % nN;
        const char* nA = has_next ? (const char*)A + (size_t)pmn * 2 * hstepA : cA; const char* nB = has_next ? (const char*)Bt + (size_t)pnn * 2 * hstepB : cB;
        for (int t = 0; t < nt; t += 2) {
            const bool last = (t == nt - 2);
            const char* a1 = cA + (size_t)(t + 1) * kstep;
            const char* a2 = last ? nA : cA + (size_t)(t + 2) * kstep; const char* b2 = last ? nB : cB + (size_t)(t + 2) * kstep;
            const char* a3 = a2 + kstep; const char* b3 = b2 + kstep;
            LDB(B0, 0, 0); LDB(B1, 0, 1); SCHED; LDA(At, 0, 0); STAGE(SA(1, 1), a1 + hstepA, voffA);
            WAIT_V(8); WAIT_L(0); BAR; MMA(0, 0, At, B0); MMA(0, 1, At, B1); BAR; SCHED;
            LDA(At, 0, 1); STAGE(SB(0, 0), b2, voffB); STAGE(SB(0, 1), b2 + hstepB, voffB); STAGE(SA(0, 0), a2, voffA);
            WAIT_V(8); WAIT_L(0); BAR; MMA(1, 0, At, B0); MMA(1, 1, At, B1); BAR; SCHED;
            LDB(B0, 1, 0); LDB(B1, 1, 1); SCHED; LDA(At, 1, 0); STAGE(SA(0, 1), a2 + hstepA, voffA);
            WAIT_V(8); WAIT_L(0); BAR; MMA(0, 0, At, B0); MMA(0, 1, At, B1); BAR; SCHED;
            LDA(At, 1, 1); STAGE(SB(1, 0), b3, voffB); STAGE(SB(1, 1), b3 + hstepB, voffB); STAGE(SA(1, 0), a3, voffA);
            WAIT_V(8); WAIT_L(0); BAR; MMA(1, 0, At, B0); MMA(1, 1, At, B1); BAR; SCHED;
        }
        epi(acc, pm * BM, pn * BM, wr, wc, fr, fq, lane);
        if (!has_next) break;
        ZACC;
        w = wn; pm = pmn; pn = pnn; cA = nA; cB = nB;
    }
    WAIT_V(0);
    if (wr == 0) BAR;
    BAR;
#undef SA
#undef SB
#undef STAGE
#undef LDA
#undef LDB
#undef MMA
#undef ZACC
}
}

__device__ __forceinline__ void norm_rows(const Ctx& cx, const float* src0, const float* src1, int split, const float* __restrict__ g, bf16_t* dst, int nrows) {
    const int lane = cx.tid & 63, gw = cx.bid * 8 + (cx.tid >> 6), nw = cx.nb * 8;
    f32x4 gv[4];
#pragma unroll
    for (int i = 0; i < 4; ++i) gv[i] = *(const f32x4*)(g + i * 256 + lane * 4);
    for (int row = gw; row < nrows; row += nw) {
        const float* s = row < split ? src0 + (size_t)row * 1024 : src1 + (size_t)(row - split) * 1024;
        f32x4 v[4]; float ss = 0.f;
#pragma unroll
        for (int i = 0; i < 4; ++i) { v[i] = *(const f32x4*)(s + i * 256 + lane * 4); ss += v[i][0] * v[i][0] + v[i][1] * v[i][1] + v[i][2] * v[i][2] + v[i][3] * v[i][3]; }
        ss = wave_sum(ss, lane);
        const float rs = rsqrtf(ss * (1.0f / 1024.0f) + EPS);
#pragma unroll
        for (int i = 0; i < 4; ++i) { u32x2 w; w.x = cvtpk(v[i][0] * rs * gv[i][0], v[i][1] * rs * gv[i][1]); w.y = cvtpk(v[i][2] * rs * gv[i][2], v[i][3] * rs * gv[i][3]);
            *(u32x2*)(dst + (size_t)row * 1024 + i * 256 + lane * 4) = w; }
    }
}

__device__ __forceinline__ void xcast_rows(const Ctx& cx, const float* src0, const float* src1, int split, bf16_t* dst, float* ss, int nrows) {
    const int lane = cx.tid & 63, gw = cx.bid * 8 + (cx.tid >> 6), nw = cx.nb * 8;
    for (int row = gw; row < nrows; row += nw) {
        const float* sp = row < split ? src0 + (size_t)row * 1024 : src1 + (size_t)(row - split) * 1024;
        f32x4 v[4]; float sq = 0.f;
#pragma unroll
        for (int i = 0; i < 4; ++i) { v[i] = *(const f32x4*)(sp + i * 256 + lane * 4); sq += v[i][0] * v[i][0] + v[i][1] * v[i][1] + v[i][2] * v[i][2] + v[i][3] * v[i][3]; }
        sq = wave_sum(sq, lane);
#pragma unroll
        for (int i = 0; i < 4; ++i) { u32x2 w; w.x = cvtpk(v[i][0], v[i][1]); w.y = cvtpk(v[i][2], v[i][3]); *(u32x2*)(dst + (size_t)row * 1024 + i * 256 + lane * 4) = w; }
        if (lane < 16) ss[(size_t)row * 16 + lane] = lane == 0 ? sq : 0.f;
    }
}

template <class F>
__device__ __forceinline__ void wconv(const Ctx& cx, bf16_t* dst, int Np, int Kp, F src) {
    LAS unsigned char* lds = (LAS unsigned char*)smem;
    const int tid = cx.tid, tn = Np >> 6, tk = Kp >> 6, ntile = tn * tk;
    const int rk = tid >> 3, rn8 = (tid & 7) * 8;
    for (int t = cx.bid; t < ntile; t += cx.nb) {
        const int n0 = (t % tn) << 6, k0 = (t / tn) << 6;
#pragma unroll
        for (int i = 0; i < 8; ++i) { const float v = src(n0 + rn8 + i, k0 + rk); const unsigned w = cvtpk(v, 0.f);
            *(LAS unsigned short*)(lds + (rn8 + i) * 144 + rk * 2) = (unsigned short)w; }
        __syncthreads();
        const u32x4 o = *(const LAS u32x4*)(lds + rk * 144 + rn8 * 2);
        *(u32x4*)(dst + (size_t)(n0 + rk) * Kp + k0 + rn8) = o;
        __syncthreads();
    }
}

__device__ __forceinline__ void prologue(const Ctx& cx, PP p) {
    bf16_t* W = (bf16_t*)(p->ws + OFF_W);
    for (int l = 0; l < 2; ++l) {
        bf16_t* Wl = W + (size_t)l * W_LAYER_E;
        { const float* s = p->in[5] + (size_t)l * 1024 * 1952; const float* g = p->in[4] + l * 1024; wconv(cx, Wl + WO_IN, 2048, 1024, [=](int n, int k) -> float { return n < 1952 ? s[(size_t)k * 1952 + n] * g[k] : 0.f; }); }
        { const float* uq = p->in[10] + (size_t)l * 256 * 768; const float* ukv = p->in[11] + (size_t)l * 128 * 1024;
          wconv(cx, Wl + WO_QKV, 2048, 384, [=](int n, int k) -> float { const int h = n >> 8, j = n & 255;
              if (j < 96) return k < 256 ? uq[(size_t)k * 768 + h * 96 + j] : 0.f;
              if (j < 160) return k >= 256 ? ukv[(size_t)(k - 256) * 1024 + h * 128 + (j - 96)] : 0.f;
              if (j < 192) return 0.f;
              return k >= 256 ? ukv[(size_t)(k - 256) * 1024 + h * 128 + 64 + (j - 192)] : 0.f; }); }
        { const float* s = p->in[16] + (size_t)l * 1024 * 1024; wconv(cx, Wl + WO_OUT, 1024, 1024, [=](int n, int k) -> float { return s[(size_t)k * 1024 + n]; }); }
        { const float* s = p->in[19] + (size_t)l * 1024 * 512; const float* g = p->in[17] + l * 1024; wconv(cx, Wl + WO_MQ, 512, 1024, [=](int n, int k) -> float { return s[(size_t)k * 512 + n] * g[k]; }); }
        { const float* s = p->in[20] + (size_t)l * 1024 * 1024; wconv(cx, Wl + WO_MKV, 1024, 1024, [=](int n, int k) -> float { return s[(size_t)k * 1024 + n]; }); }
        { const float* s = p->in[23] + (size_t)l * 512 * 1024; wconv(cx, Wl + WO_MO, 1024, 512, [=](int n, int k) -> float { return s[(size_t)k * 1024 + n]; }); }
        { const float* s = p->in[25] + (size_t)l * 1024 * 4096; const float* g = p->in[24] + l * 1024; wconv(cx, Wl + WO_1, 4096, 1024, [=](int n, int k) -> float { return s[(size_t)k * 4096 + n] * g[k]; }); }
        { const float* s = p->in[26] + (size_t)l * 4096 * 1024; wconv(cx, Wl + WO_2, 1024, 4096, [=](int n, int k) -> float { return s[(size_t)k * 1024 + n]; }); }
    }
    float2* cs = (float2*)(p->ws + OFF_CS);
    const int gt = cx.bid * 512 + cx.tid, nt = cx.nb * 512;
    for (int idx = gt; idx < 8192 * 16; idx += nt) { const int pos = idx >> 4, j = idx & 15;
        double inv = 1.0; for (int k = 0; k < j; ++k) inv *= 0.44036660267178046;
        double tt = (double)pos * inv * 0.15915494309189535; tt -= floor(tt);
        const float fr = (float)tt; cs[idx] = make_float2(__builtin_amdgcn_cosf(fr), __builtin_amdgcn_sinf(fr)); }
}

__device__ __forceinline__ void prep_a(const Ctx& cx, PP p, int l) {
    bf16_t* PROJ = (bf16_t*)(p->ws + OFF_RA); bf16_t* KVM = (bf16_t*)(p->ws + OFF_KVM); const float2* cs = (const float2*)(p->ws + OFF_CS);
    const int lane = cx.tid & 63, gw = cx.bid * 8 + (cx.tid >> 6), nw = cx.nb * 8;
    const int seg = lane & 7;
    float gq[8], gk[8], gcq[4], gckv[2], gkm[8];
#pragma unroll
    for (int i = 0; i < 8; ++i) { gq[i] = p->in[6][l * 64 + seg * 8 + i]; gk[i] = p->in[7][l * 64 + seg * 8 + i]; gkm[i] = p->in[22][l * 128 + (lane & 15) * 8 + i]; }
#pragma unroll
    for (int i = 0; i < 4; ++i) gcq[i] = p->in[8][l * 256 + lane * 4 + i];
    gckv[0] = p->in[9][l * 128 + lane * 2]; gckv[1] = p->in[9][l * 128 + lane * 2 + 1];
    const float qscale = 0.125f * LOG2E;
    for (int tok = gw; tok < T; tok += nw) {
        int seqbase, S; seq_of_tok(tok, seqbase, S); const int pos = tok - seqbase;
        bf16_t* R = PROJ + (size_t)tok * LDP;
        float2 c = make_float2(1.f, 0.f);
        float cc[8], sn[8];
#pragma unroll
        for (int i = 0; i < 8; ++i) { const float2 t = cs[pos * 16 + 2 * i]; cc[i] = seg < 2 ? t.x : 1.0f; sn[i] = seg == 0 ? -t.y : (seg == 1 ? t.y : 0.0f); }
        (void)c;
#pragma unroll
        for (int which = 0; which < 2; ++which) {
            bf16_t* ptr = R + which * 512 + lane * 8; float f[8]; unpack8(*(const u32x4*)ptr, f);
            float ss = 0.f;
#pragma unroll
            for (int i = 0; i < 8; ++i) ss += f[i] * f[i];
            ss = sum8(ss);
            const float rs = rsqrtf(ss * (1.0f / 64.0f) + EPS);
#pragma unroll
            for (int i = 0; i < 8; ++i) f[i] = f[i] * rs * (which == 0 ? gq[i] : gk[i]);
            float o[8];
#pragma unroll
            for (int i = 0; i < 8; ++i) { const float pr = dppf<DPP_XOR1>(f[i]); o[i] = f[i] * cc[i] + pr * sn[i]; }
            if (which == 0) {
#pragma unroll
                for (int i = 0; i < 8; ++i) o[i] *= qscale; }
            *(u32x4*)ptr = pack8(o);
        }
        { bf16_t* ptr = R + 1536 + lane * 4; const u32x2 v = *(const u32x2*)ptr; float f[4] = {bflo(v.x), bfhi(v.x), bflo(v.y), bfhi(v.y)};
          float ss = sum64(f[0] * f[0] + f[1] * f[1] + f[2] * f[2] + f[3] * f[3], lane); const float rs = rsqrtf(ss * (1.0f / 256.0f) + EPS);
          u32x2 w; w.x = cvtpk(f[0] * rs * gcq[0], f[1] * rs * gcq[1]); w.y = cvtpk(f[2] * rs * gcq[2], f[3] * rs * gcq[3]); *(u32x2*)ptr = w; }
        { bf16_t* ptr = R + 1792 + lane * 2; const unsigned v = *(const unsigned*)ptr; float f0 = bflo(v), f1 = bfhi(v);
          float ss = sum64(f0 * f0 + f1 * f1, lane); const float rs = rsqrtf(ss * (1.0f / 128.0f) + EPS);
          *(unsigned*)ptr = cvtpk(f0 * rs * gckv[0], f1 * rs * gckv[1]); }
    }
}

__device__ __forceinline__ void prep_b(const Ctx& cx, PP p, int l) {
    const bf16_t* PROJ = (const bf16_t*)(p->ws + OFF_RA); bf16_t* QKVB = (bf16_t*)(p->ws + OFF_RB); const float2* cs = (const float2*)(p->ws + OFF_CS);
    const int lane = cx.tid & 63, gw = cx.bid * 8 + (cx.tid >> 6), nw = cx.nb * 8;
    const int h = lane >> 3, seg = lane & 7; const bool active = seg < 6; const int sg = active ? seg : 5;
    float gq[16], gk[16];
#pragma unroll
    for (int i = 0; i < 16; ++i) { gq[i] = p->in[12][l * 96 + sg * 16 + i]; gk[i] = p->in[13][l * 96 + sg * 16 + i]; }
    const float qscale = 0.10206207261596577f * LOG2E;
    for (int tok = gw; tok < T; tok += nw) {
        int seqbase, S; seq_of_tok(tok, seqbase, S); const int pos = tok - seqbase;
        bf16_t* R = QKVB + (size_t)tok * LDP + h * 256;
        float cm[16], sm[16];
#pragma unroll
        for (int i = 0; i < 16; ++i) { const float2 t = cs[pos * 16 + i]; cm[i] = seg == 4 || seg == 5 ? t.x : 1.0f; sm[i] = seg == 4 ? -t.y : (seg == 5 ? t.y : 0.0f); }
#pragma unroll
        for (int which = 0; which < 2; ++which) {
            const bf16_t* src = which == 0 ? R + sg * 16 : (sg < 4 ? R + 96 + sg * 16 : PROJ + (size_t)tok * LDP + 1920 + (sg - 4) * 16);
            bf16_t* dst = R + which * 96 + sg * 16;
            float f[16]; unpack8(*(const u32x4*)src, f); unpack8(*(const u32x4*)(src + 8), f + 8);
            float ss = 0.f;
#pragma unroll
            for (int i = 0; i < 16; ++i) ss += f[i] * f[i];
            const float tot = sum8(active ? ss : 0.f);
            const float rs = rsqrtf(tot * (1.0f / 96.0f) + EPS);
#pragma unroll
            for (int i = 0; i < 16; ++i) f[i] = f[i] * rs * (which == 0 ? gq[i] : gk[i]);
            float o[16];
#pragma unroll
            for (int i = 0; i < 16; ++i) { const float pr = dppf<DPP_XOR1>(f[i]); o[i] = f[i] * cm[i] + pr * sm[i]; }
            if (which == 0) {
#pragma unroll
                for (int i = 0; i < 16; ++i) o[i] *= qscale; }
            if (active) { *(u32x4*)dst = pack8(o); *(u32x4*)(dst + 8) = pack8(o + 8); }
        }
    }
}

__device__ __forceinline__ void out_norm(const Ctx& cx, PP p, int l) {
    bf16_t* PROJ = (bf16_t*)(p->ws + OFF_RA);
    const int lane = cx.tid & 63, gw = cx.bid * 8 + (cx.tid >> 6), nw = cx.nb * 8;
    float ga[8], gb[8];
#pragma unroll
    for (int i = 0; i < 8; ++i) { ga[i] = p->in[14][l * 512 + lane * 8 + i]; gb[i] = p->in[15][l * 512 + lane * 8 + i]; }
    for (int tok = gw; tok < T; tok += nw) {
        bf16_t* R = PROJ + (size_t)tok * LDP; float a[8], b[8];
        unpack8(*(const u32x4*)(R + lane * 8), a); unpack8(*(const u32x4*)(R + 1536 + lane * 8), b);
        float sa = 0.f, sb = 0.f;
#pragma unroll
        for (int i = 0; i < 8; ++i) { sa += a[i] * a[i]; sb += b[i] * b[i]; }
        sa = sum64(sa, lane); sb = sum64(sb, lane);
        const float ra = rsqrtf(sa * (1.0f / 512.0f) + EPS), rb = rsqrtf(sb * (1.0f / 512.0f) + EPS);
#pragma unroll
        for (int i = 0; i < 8; ++i) { a[i] = a[i] * ra * ga[i]; b[i] = b[i] * rb * gb[i]; }
        *(u32x4*)(R + lane * 8) = pack8(a); *(u32x4*)(R + 512 + lane * 8) = pack8(b);
    }
}

#define MFMA16(a, b, c) __builtin_amdgcn_mfma_f32_16x16x32_bf16(a, b, c, 0, 0, 0)
__device__ __forceinline__ s16x4 vtr(const LAS unsigned char* p) { return __builtin_bit_cast(s16x4, __builtin_amdgcn_ds_read_tr16_b64_v4i16((LAS v4i16_t*)p)); }

template <int DQK, int DV, int KT, int QG, bool QNORM>
__device__ __forceinline__ void attn_dense(const Ctx& cx, const bf16_t* Q, int ldq, const bf16_t* Kb, int ldk, const bf16_t* Vb, int ldv, int nkeys,
                                           bf16_t* O, int ldo, const float* qgain, float qscale) {
    constexpr int KC = DQK / 32, DVT = DV / 16, KSTR = DQK * 2 + 16, VSTR = (DV == 64) ? 160 : 288;
    constexpr int KBUF = KT * KSTR, VBUF = KT * VSTR, STG = KBUF + VBUF;
    constexpr int KCPR = DQK / 8, VCPR = DV / 8, KPER = KT * KCPR / 512, VPER = KT * VCPR / 512;
    static_assert(2 * STG <= LDS_BYTES, "LDS");
    const int tid = cx.tid, wid = tid >> 6, lane = tid & 63, fr = lane & 15, fq = lane >> 4;
    LAS unsigned char* lds = (LAS unsigned char*)smem;
    bf16x8 qf[QG][KC];
#pragma unroll
    for (int qg = 0; qg < QG; ++qg) {
        const bf16_t* qp = Q + (size_t)(wid * 16 * QG + qg * 16 + fr) * ldq;
        if (QNORM) {
            float f[KC][8]; float ss = 0.f;
#pragma unroll
            for (int kc = 0; kc < KC; ++kc) { unpack8(*(const u32x4*)(qp + kc * 32 + fq * 8), f[kc]);
#pragma unroll
                for (int i = 0; i < 8; ++i) ss += f[kc][i] * f[kc][i]; }
            ss += shx(ss, 16, lane); ss += shx(ss, 32, lane);
            const float rs = rsqrtf(ss * (1.0f / DQK) + EPS) * qscale;
#pragma unroll
            for (int kc = 0; kc < KC; ++kc) {
#pragma unroll
                for (int i = 0; i < 8; ++i) f[kc][i] = f[kc][i] * rs * qgain[kc * 32 + fq * 8 + i];
                qf[qg][kc] = __builtin_bit_cast(bf16x8, pack8(f[kc])); }
        } else {
#pragma unroll
            for (int kc = 0; kc < KC; ++kc) qf[qg][kc] = *(const bf16x8*)(qp + kc * 32 + fq * 8);
        }
    }
    float mrun[QG], lrun[QG]; f32x4 o[QG][DVT];
#pragma unroll
    for (int qg = 0; qg < QG; ++qg) { mrun[qg] = -1e30f; lrun[qg] = 0.f;
#pragma unroll
        for (int d = 0; d < DVT; ++d) o[qg][d] = (f32x4){0.f, 0.f, 0.f, 0.f}; }
    u32x4 kreg[KPER], vreg[VPER];
    const int ntiles = nkeys / KT;
#pragma unroll
    for (int i = 0; i < KPER; ++i) { const int c = tid + i * 512, row = c / KCPR, cc = c % KCPR; kreg[i] = *(const u32x4*)(Kb + (size_t)row * ldk + cc * 8); }
#pragma unroll
    for (int i = 0; i < VPER; ++i) { const int c = tid + i * 512, row = c / VCPR, cc = c % VCPR; vreg[i] = *(const u32x4*)(Vb + (size_t)row * ldv + cc * 8); }
#pragma unroll
    for (int i = 0; i < KPER; ++i) { const int c = tid + i * 512, row = c / KCPR, cc = c % KCPR; *(LAS u32x4*)(lds + row * KSTR + cc * 16) = kreg[i]; }
#pragma unroll
    for (int i = 0; i < VPER; ++i) { const int c = tid + i * 512, row = c / VCPR, cc = c % VCPR; *(LAS u32x4*)(lds + KBUF + row * VSTR + cc * 16) = vreg[i]; }
    __syncthreads();
    for (int t = 0; t < ntiles; ++t) {
        const bool more = t + 1 < ntiles;
        if (more) {
            const int k0 = (t + 1) * KT;
#pragma unroll
            for (int i = 0; i < KPER; ++i) { const int c = tid + i * 512, row = c / KCPR, cc = c % KCPR; kreg[i] = *(const u32x4*)(Kb + (size_t)(k0 + row) * ldk + cc * 8); }
#pragma unroll
            for (int i = 0; i < VPER; ++i) { const int c = tid + i * 512, row = c / VCPR, cc = c % VCPR; vreg[i] = *(const u32x4*)(Vb + (size_t)(k0 + row) * ldv + cc * 8); }
        }
        const LAS unsigned char* Kl = lds + (t & 1) * STG; const LAS unsigned char* Vl = Kl + KBUF;
#pragma unroll
        for (int sub = 0; sub < KT / 64; ++sub) {
            f32x4 s[QG][4];
#pragma unroll
            for (int qg = 0; qg < QG; ++qg)
#pragma unroll
                for (int kt = 0; kt < 4; ++kt) s[qg][kt] = (f32x4){0.f, 0.f, 0.f, 0.f};
#pragma unroll
            for (int kt = 0; kt < 4; ++kt)
#pragma unroll
                for (int kc = 0; kc < KC; ++kc) { const bf16x8 a = *(const LAS bf16x8*)(Kl + (sub * 64 + kt * 16 + fr) * KSTR + (kc * 32 + fq * 8) * 2);
#pragma unroll
                    for (int qg = 0; qg < QG; ++qg) s[qg][kt] = MFMA16(a, qf[qg][kc], s[qg][kt]); }
            bf16x8 pb[QG][2];
#pragma unroll
            for (int qg = 0; qg < QG; ++qg) {
                float mx = s[qg][0][0];
#pragma unroll
                for (int kt = 0; kt < 4; ++kt)
#pragma unroll
                    for (int j = 0; j < 4; ++j) mx = fmaxf(mx, s[qg][kt][j]);
                mx = fmaxf(mx, shx(mx, 16, lane)); mx = fmaxf(mx, shx(mx, 32, lane));
                const float mn = fmaxf(mrun[qg], mx), alpha = __builtin_amdgcn_exp2f(mrun[qg] - mn); mrun[qg] = mn;
                float rsum = 0.f;
#pragma unroll
                for (int kt = 0; kt < 4; ++kt)
#pragma unroll
                    for (int j = 0; j < 4; ++j) { const float pv = __builtin_amdgcn_exp2f(s[qg][kt][j] - mn); s[qg][kt][j] = pv; rsum += pv; }
                lrun[qg] = lrun[qg] * alpha + rsum;
#pragma unroll
                for (int d = 0; d < DVT; ++d) o[qg][d] = o[qg][d] * alpha;
#pragma unroll
                for (int t2 = 0; t2 < 2; ++t2) { u32x4 w; w.x = cvtpk(s[qg][2 * t2][0], s[qg][2 * t2][1]); w.y = cvtpk(s[qg][2 * t2][2], s[qg][2 * t2][3]);
                    w.z = cvtpk(s[qg][2 * t2 + 1][0], s[qg][2 * t2 + 1][1]); w.w = cvtpk(s[qg][2 * t2 + 1][2], s[qg][2 * t2 + 1][3]); pb[qg][t2] = __builtin_bit_cast(bf16x8, w); }
            }
#pragma unroll
            for (int t2 = 0; t2 < 2; ++t2)
#pragma unroll
                for (int d = 0; d < DVT; ++d) {
                    const LAS unsigned char* vp = Vl + (sub * 64 + t2 * 32 + fq * 4 + (fr >> 2)) * VSTR + (d * 16 + 4 * (fr & 3)) * 2;
                    const s16x4 lo = vtr(vp), hi = vtr(vp + 16 * VSTR);
                    const bf16x8 a = __builtin_shufflevector(lo, hi, 0, 1, 2, 3, 4, 5, 6, 7);
#pragma unroll
                    for (int qg = 0; qg < QG; ++qg) o[qg][d] = MFMA16(a, pb[qg][t2], o[qg][d]);
                }
        }
        if (more) {
            LAS unsigned char* Kn = lds + ((t + 1) & 1) * STG;
#pragma unroll
            for (int i = 0; i < KPER; ++i) { const int c = tid + i * 512, row = c / KCPR, cc = c % KCPR; *(LAS u32x4*)(Kn + row * KSTR + cc * 16) = kreg[i]; }
#pragma unroll
            for (int i = 0; i < VPER; ++i) { const int c = tid + i * 512, row = c / VCPR, cc = c % VCPR; *(LAS u32x4*)(Kn + KBUF + row * VSTR + cc * 16) = vreg[i]; }
        }
        __syncthreads();
    }
#pragma unroll
    for (int qg = 0; qg < QG; ++qg) {
        float lt = lrun[qg]; lt += shx(lt, 16, lane); lt += shx(lt, 32, lane);
        const float inv = 1.0f / lt;
        bf16_t* op = O + (size_t)(wid * 16 * QG + qg * 16 + fr) * ldo + fq * 4;
#pragma unroll
        for (int d = 0; d < DVT; ++d) { u32x2 w; w.x = cvtpk(o[qg][d][0] * inv, o[qg][d][1] * inv); w.y = cvtpk(o[qg][d][2] * inv, o[qg][d][3] * inv); *(u32x2*)(op + d * 16) = w; }
    }
}

typedef float f32x16 __attribute__((ext_vector_type(16)));
#define MFMA32(a, b, c) __builtin_amdgcn_mfma_f32_32x32x16_bf16(a, b, c, 0, 0, 0)
__device__ __forceinline__ void attn_mla(const Ctx& cx, const bf16_t* Q, const bf16_t* Kb, const bf16_t* Vb, int nkeys, bf16_t* O) {
    constexpr int KT = 128, KSTR = 208, VSTR = 192, KBUF = KT * KSTR, VBUF = KT * VSTR, STG = KBUF + VBUF;
    static_assert(2 * STG <= LDS_BYTES, "LDS");
    const int tid = cx.tid, wid = tid >> 6, lane = tid & 63, c = lane & 31, hi = lane >> 5;
    LAS unsigned char* lds = (LAS unsigned char*)smem;
    bf16x8 qf[6];
    { const bf16_t* qp = Q + (size_t)(wid * 32 + c) * LDP + hi * 8;
#pragma unroll
      for (int kc = 0; kc < 6; ++kc) qf[kc] = *(const bf16x8*)(qp + kc * 16); }
    f32x16 o[2], negm;
#pragma unroll
    for (int i = 0; i < 16; ++i) { o[0][i] = 0.f; o[1][i] = 0.f; negm[i] = 0.f; }
    float lrun = 0.f;
    u32x4 kreg[3], vreg[2];
    const int ntiles = nkeys / KT;
    const bool grpB = false;
    const int koff = c * KSTR + hi * 16;
    const int voff = (4 * hi + ((lane & 15) >> 2)) * VSTR + (((lane >> 4) & 1) * 16 + 4 * (lane & 3)) * 2;
    const unsigned kgo = (unsigned)((tid >> 2) * LDP + (tid & 3) * 8) * 2u, vgo = (unsigned)((tid >> 3) * LDP + (tid & 7) * 8) * 2u;
    const int klo = (tid >> 2) * KSTR + (tid & 3) * 16, vlo = KBUF + (tid >> 3) * VSTR + (tid & 7) * 16;
    const char* Kg = (const char*)Kb; const char* Vg = (const char*)Vb;
#define MLA_GLOAD(k0) do { unsigned kgo_ = kgo, vgo_ = vgo; asm volatile("" : "+v"(kgo_), "+v"(vgo_));   \
    _Pragma("unroll") for (int i = 0; i < 3; ++i) kreg[i] = *(const u32x4*)(Kg + (size_t)(k0) * (LDP * 2) + kgo_ + i * 64); \
    _Pragma("unroll") for (int i = 0; i < 2; ++i) vreg[i] = *(const u32x4*)(Vg + (size_t)((k0) + 64 * i) * (LDP * 2) + vgo_); } while (0)
#define MLA_LWRITE(buf) do { LAS unsigned char* Kn = lds + (buf) * STG; \
    _Pragma("unroll") for (int i = 0; i < 3; ++i) *(LAS u32x4*)(Kn + klo + i * 64) = kreg[i]; \
    _Pragma("unroll") for (int i = 0; i < 2; ++i) *(LAS u32x4*)(Kn + vlo + i * 64 * VSTR) = vreg[i]; } while (0)
#define MLA_QK(dst, kbase) do { _Pragma("unroll") for (int kc = 0; kc < 6; ++kc) { \
        _Pragma("unroll") for (int kb = 0; kb < 2; ++kb) { const bf16x8 a_ = *(const LAS bf16x8*)((kbase) + kb * 32 * KSTR + koff + kc * 32); dst[kb] = MFMA32(a_, qf[kc], kc == 0 ? negm : dst[kb]); } } } while (0)
#define MLA_CHECK(sc) do { float mxl_ = sc[0][0]; \
        _Pragma("unroll") for (int kb = 0; kb < 2; ++kb) _Pragma("unroll") for (int i = 0; i < 16; ++i) mxl_ = fmaxf(mxl_, sc[kb][i]); \
        if (__builtin_amdgcn_ballot_w64(mxl_ > 8.0f) != 0ull) { \
            float dl_ = fmaxf(mxl_, shx(mxl_, 32, lane)); dl_ = fmaxf(dl_, 0.f); const float al_ = __builtin_amdgcn_exp2f(-dl_); lrun *= al_; \
            _Pragma("unroll") for (int i = 0; i < 16; ++i) { o[0][i] *= al_; o[1][i] *= al_; negm[i] -= dl_; sc[0][i] -= dl_; sc[1][i] -= dl_; } } } while (0)
    MLA_GLOAD(0); MLA_LWRITE(0);
    __syncthreads();
    f32x16 sa[2], sb[2];
    MLA_QK(sa, lds);
    {
        float mxl = sa[0][0];
#pragma unroll
        for (int kb = 0; kb < 2; ++kb)
#pragma unroll
            for (int i = 0; i < 16; ++i) mxl = fmaxf(mxl, sa[kb][i]);
        const float mx = fmaxf(mxl, shx(mxl, 32, lane));
#pragma unroll
        for (int i = 0; i < 16; ++i) { negm[i] = -mx; sa[0][i] -= mx; sa[1][i] -= mx; }
    }
    bf16x8 pb[2][2];
#define MLA_EXP(sc) do { float rs_ = 0.f; _Pragma("unroll") for (int kb = 0; kb < 2; ++kb) { \
        _Pragma("unroll") for (int i = 0; i < 16; ++i) { const float pv_ = __builtin_amdgcn_exp2f(sc[kb][i]); sc[kb][i] = pv_; rs_ += pv_; } \
        _Pragma("unroll") for (int t2 = 0; t2 < 2; ++t2) { u32x4 w_; w_.x = cvtpk(sc[kb][8 * t2 + 0], sc[kb][8 * t2 + 1]); w_.y = cvtpk(sc[kb][8 * t2 + 2], sc[kb][8 * t2 + 3]); \
            w_.z = cvtpk(sc[kb][8 * t2 + 4], sc[kb][8 * t2 + 5]); w_.w = cvtpk(sc[kb][8 * t2 + 6], sc[kb][8 * t2 + 7]); pb[kb][t2] = __builtin_bit_cast(bf16x8, w_); } } lrun += rs_; } while (0)
#define MLA_PV(vbase) do { _Pragma("unroll") for (int kb = 0; kb < 2; ++kb) _Pragma("unroll") for (int t2 = 0; t2 < 2; ++t2) _Pragma("unroll") for (int d = 0; d < 2; ++d) { \
        const LAS unsigned char* vp_ = (vbase) + (kb * 32 + t2 * 16) * VSTR + voff + d * 64; const s16x4 lo_ = vtr(vp_), hh_ = vtr(vp_ + 8 * VSTR); \
        o[d] = MFMA32(__builtin_shufflevector(lo_, hh_, 0, 1, 2, 3, 4, 5, 6, 7), pb[kb][t2], o[d]); } } while (0)
#define MLA_SCHED_QK_EXP do { _Pragma("unroll") for (int i_ = 0; i_ < 12; ++i_) { __builtin_amdgcn_sched_group_barrier(0x008, 1, 0); __builtin_amdgcn_sched_group_barrier(0x100, 1, 0); __builtin_amdgcn_sched_group_barrier(0x002, 8, 0); } } while (0)
    for (int t = 0; t < ntiles; ++t) {
        const bool more = t + 1 < ntiles;
        const LAS unsigned char* Kl = lds + (t & 1) * STG; const LAS unsigned char* Vl = Kl + KBUF;
        if (more) MLA_GLOAD((t + 1) * KT);
        if (grpB) { MLA_EXP(sa); MLA_PV(Vl); MLA_QK(sb, Kl + 64 * KSTR); }
        else { MLA_QK(sb, Kl + 64 * KSTR); MLA_EXP(sa); MLA_PV(Vl); }
        MLA_CHECK(sb);
        __syncthreads();
        if (more) MLA_LWRITE((t + 1) & 1);
        __syncthreads();
        if (grpB) { MLA_EXP(sb); MLA_PV(Vl + 64 * VSTR); if (more) { MLA_QK(sa, lds + ((t + 1) & 1) * STG); } }
        else { if (more) { MLA_QK(sa, lds + ((t + 1) & 1) * STG); } MLA_EXP(sb); MLA_PV(Vl + 64 * VSTR); }
        if (more) { MLA_CHECK(sa); }
    }
#undef MLA_GLOAD
#undef MLA_LWRITE
#undef MLA_QK
#undef MLA_CHECK
#undef MLA_EXP
#undef MLA_PV
#undef MLA_SCHED_QK_EXP
    float lt = lrun; lt += shx(lt, 32, lane);
    const float inv = 1.0f / lt;
    int le_; asm volatile("v_mbcnt_lo_u32_b32 %0, -1, 0\n\tv_mbcnt_hi_u32_b32 %0, -1, %0" : "=v"(le_));
    bf16_t* op = O + (size_t)(__builtin_amdgcn_readfirstlane(wid) * 32 + (le_ & 31)) * LDP + 4 * (le_ >> 5);
#pragma unroll
    for (int d = 0; d < 2; ++d)
#pragma unroll
        for (int g = 0; g < 4; ++g) { u32x2 w; w.x = cvtpk(o[d][4 * g] * inv, o[d][4 * g + 1] * inv); w.y = cvtpk(o[d][4 * g + 2] * inv, o[d][4 * g + 3] * inv); *(u32x2*)(op + d * 32 + 8 * g) = w; }
    __syncthreads();
}

template <int MODE>
__device__ __forceinline__ void win_load(const bf16_t* Kbase, const bf16_t* Vbase, int S, int d, int kb, unsigned koff, unsigned voffs, int lane, bf16x8 (&kf)[2][2], u32x4 (&vv)[4]) {
    const int fr = lane & 15, fq = lane >> 4; (void)fr; (void)fq;
    if (MODE == 0) {
#pragma unroll
        for (int kt = 0; kt < 2; ++kt) { int pk = kb + d * (kt * 16 + fr); pk = pk < 0 ? 0 : (pk > S - 1 ? S - 1 : pk);
            const bf16_t* kp = Kbase + (size_t)pk * LDP; kf[kt][0] = *(const bf16x8*)(kp + fq * 8); kf[kt][1] = *(const bf16x8*)(kp + 32 + fq * 8); }
#pragma unroll
        for (int c = 0; c < 4; ++c) { int pk = kb + d * (c * 8 + (lane >> 3)); pk = pk < 0 ? 0 : (pk > S - 1 ? S - 1 : pk);
            vv[c] = *(const u32x4*)(Vbase + (size_t)pk * LDP + (lane & 7) * 8); }
    } else {
#pragma unroll
        for (int kt = 0; kt < 2; ++kt) { const char* ku = (const char*)(Kbase + (size_t)(kb + d * kt * 16) * LDP);
            kf[kt][0] = *(const bf16x8*)(ku + koff); kf[kt][1] = *(const bf16x8*)(ku + 64 + koff); }
#pragma unroll
        for (int c = 0; c < 4; ++c) { const char* vu = (const char*)(Vbase + (size_t)(kb + d * c * 8) * LDP); vv[c] = *(const u32x4*)(vu + voffs); }
    }
}
template <int MODE>
__device__ __forceinline__ void win_compute(int S, int d, int W, int kb, int pq, int i0, const bf16x8 (&kf)[2][2], const u32x4 (&vv)[4],
                                            const bf16x8 (&qf)[2], LAS unsigned char* vl, int lane, float& mrun, float& lrun, f32x4 (&o)[4]) {
    const int fr = lane & 15, fq = lane >> 4;
#pragma unroll
    for (int c = 0; c < 4; ++c) *(LAS u32x4*)(vl + (c * 8 + (lane >> 3)) * 160 + (lane & 7) * 16) = vv[c];
    f32x4 s[2];
#pragma unroll
    for (int kt = 0; kt < 2; ++kt) s[kt] = (f32x4){0.f, 0.f, 0.f, 0.f};
    s[0] = MFMA16(kf[0][0], qf[0], s[0]); s[1] = MFMA16(kf[1][0], qf[0], s[1]); s[0] = MFMA16(kf[0][1], qf[1], s[0]); s[1] = MFMA16(kf[1][1], qf[1], s[1]);
    bool valid[2][4]; float mx = -1e30f;
#pragma unroll
    for (int kt = 0; kt < 2; ++kt)
#pragma unroll
        for (int j = 0; j < 4; ++j) {
            if (MODE == 0) { const int pk = kb + d * (kt * 16 + fq * 4 + j); const int dl = pk - pq; valid[kt][j] = (pk >= 0) && (pk < S) && (dl <= W) && (dl >= -W); }
            else if (MODE == 1) valid[kt][j] = true;
            else if (MODE == 2) valid[kt][j] = (i0 + kt * 16 + fq * 4 + j) >= fr;
            else valid[kt][j] = (i0 + kt * 16 + fq * 4 + j) <= fr + 128;
            if (valid[kt][j]) mx = fmaxf(mx, s[kt][j]); }
    if (__builtin_amdgcn_ballot_w64(mx > mrun + 8.0f) != 0ull) {
        mx = fmaxf(mx, shx(mx, 16, lane)); mx = fmaxf(mx, shx(mx, 32, lane));
        const float mn = fmaxf(mrun, mx), alpha = __builtin_amdgcn_exp2f(mrun - mn); mrun = mn; lrun *= alpha;
#pragma unroll
        for (int dv = 0; dv < 4; ++dv) o[dv] = o[dv] * alpha;
    }
    float rsum = 0.f;
#pragma unroll
    for (int kt = 0; kt < 2; ++kt)
#pragma unroll
        for (int j = 0; j < 4; ++j) { const float pv = valid[kt][j] ? __builtin_amdgcn_exp2f(s[kt][j] - mrun) : 0.f; s[kt][j] = pv; rsum += pv; }
    lrun += rsum;
    u32x4 w; w.x = cvtpk(s[0][0], s[0][1]); w.y = cvtpk(s[0][2], s[0][3]); w.z = cvtpk(s[1][0], s[1][1]); w.w = cvtpk(s[1][2], s[1][3]);
    const bf16x8 pb = __builtin_bit_cast(bf16x8, w);
#pragma unroll
    for (int dv = 0; dv < 4; ++dv) {
        const LAS unsigned char* vp = vl + (fq * 4 + (fr >> 2)) * 160 + (dv * 16 + 4 * (fr & 3)) * 2;
        const s16x4 lo = vtr(vp), hi = vtr(vp + 16 * 160);
        const bf16x8 a = __builtin_shufflevector(lo, hi, 0, 1, 2, 3, 4, 5, 6, 7);
        o[dv] = MFMA16(a, pb, o[dv]);
    }
}

__device__ __forceinline__ void attn_win_unit(const Ctx& cx, bf16_t* PROJ, int seqbase, int S, int P0, int head, LAS unsigned char* st, LAS unsigned char* vl0) {
    const int lane = cx.tid & 63, wid = __builtin_amdgcn_readfirstlane(cx.tid >> 6), fr = lane & 15, fq = lane >> 4;
    const bf16_t* Kbase = PROJ + (size_t)seqbase * LDP + 512 + head * 64;
    const bf16_t* Vbase = PROJ + (size_t)seqbase * LDP + 1024 + head * 64;
    LAS unsigned char* vl1 = vl0 + 5120;
#pragma unroll 1
    for (int br = 0; br < 3; ++br) {
        const int d = br == 0 ? 1 : (br == 1 ? 4 : 16), W = 64 * d;
        const unsigned koff = (unsigned)(d * fr * LDP + fq * 8) * 2u, voffs = (unsigned)(d * (lane >> 3) * LDP + (lane & 7) * 8) * 2u;
        int pq[2], kb0[2]; bf16_t* qrow[2]; LAS unsigned char* sq[2]; bf16x8 qf[2][2]; float mrun[2], lrun[2]; f32x4 o[2][4];
#pragma unroll
        for (int gi = 0; gi < 2; ++gi) {
            const int idx = 2 * wid + gi;
            const int q0 = br == 0 ? 16 * idx : (br == 1 ? (idx >> 2) + 64 * (idx & 3) : idx);
            const int qrel = q0 + d * fr; pq[gi] = P0 + qrel; kb0[gi] = P0 + q0 - W;
            qrow[gi] = PROJ + (size_t)(seqbase + pq[gi]) * LDP + head * 64;
            qf[gi][0] = *(const bf16x8*)(qrow[gi] + fq * 8); qf[gi][1] = *(const bf16x8*)(qrow[gi] + 32 + fq * 8);
            sq[gi] = st + qrel * 272;
            if (br == 0) { mrun[gi] = -1e30f; lrun[gi] = 0.f;
#pragma unroll
                for (int dv = 0; dv < 4; ++dv) o[gi][dv] = (f32x4){0.f, 0.f, 0.f, 0.f};
            } else { mrun[gi] = *(const LAS float*)(sq[gi] + 256); lrun[gi] = fq == 0 ? *(const LAS float*)(sq[gi] + 260) : 0.f;
#pragma unroll
                for (int dv = 0; dv < 4; ++dv) o[gi][dv] = *(const LAS f32x4*)(sq[gi] + (dv * 16 + fq * 4) * 4); }
        }
        const bool interior = kb0[0] >= 0 && kb0[0] + 159 * d < S && kb0[1] >= 0 && kb0[1] + 159 * d < S;
#define WIN_PAIR(MD, STP) do { bf16x8 kfa_[2][2], kfb_[2][2]; u32x4 vva_[4], vvb_[4]; \
            win_load<(MD) == 0 ? 0 : 1>(Kbase, Vbase, S, d, kb0[0] + d * ((STP) * 32), koff, voffs, lane, kfa_, vva_); \
            win_load<(MD) == 0 ? 0 : 1>(Kbase, Vbase, S, d, kb0[1] + d * ((STP) * 32), koff, voffs, lane, kfb_, vvb_); \
            win_compute<MD>(S, d, W, kb0[0] + d * ((STP) * 32), pq[0], (STP) * 32, kfa_, vva_, qf[0], vl0, lane, mrun[0], lrun[0], o[0]); \
            win_compute<MD>(S, d, W, kb0[1] + d * ((STP) * 32), pq[1], (STP) * 32, kfb_, vvb_, qf[1], vl1, lane, mrun[1], lrun[1], o[1]); } while (0)
        if (interior) {
            WIN_PAIR(2, 0);
#pragma unroll 1
            for (int stp = 1; stp < 4; ++stp) WIN_PAIR(1, stp);
            WIN_PAIR(3, 4);
        } else {
#pragma unroll 1
            for (int stp = 0; stp < 5; ++stp) WIN_PAIR(0, stp);
        }
#undef WIN_PAIR
#pragma unroll
        for (int gi = 0; gi < 2; ++gi) {
            float lt = lrun[gi]; lt += shx(lt, 16, lane); lt += shx(lt, 32, lane);
            if (br < 2) {
#pragma unroll
                for (int dv = 0; dv < 4; ++dv) *(LAS f32x4*)(sq[gi] + (dv * 16 + fq * 4) * 4) = o[gi][dv];
                if (fq == 0) { *(LAS float*)(sq[gi] + 256) = mrun[gi]; *(LAS float*)(sq[gi] + 260) = lt; }
            } else {
                const float inv = 1.0f / lt;
#pragma unroll
                for (int dv = 0; dv < 4; ++dv) { u32x2 w; w.x = cvtpk(o[gi][dv][0] * inv, o[gi][dv][1] * inv); w.y = cvtpk(o[gi][dv][2] * inv, o[gi][dv][3] * inv); *(u32x2*)(qrow[gi] + dv * 16 + fq * 4) = w; }
            }
        }
        __syncthreads();
    }
}

__device__ __forceinline__ void attn_ab(const Ctx& cx, PP p, int part) {
    bf16_t* PROJ = (bf16_t*)(p->ws + OFF_RA); bf16_t* QKVB = (bf16_t*)(p->ws + OFF_RB);
    const int b = cx.bid, G = cx.nb;
    const int wid_s = __builtin_amdgcn_readfirstlane(cx.tid >> 6);
    if (part != 2) for (int u = b; u < 1536; u += G) {
        int seq, head, qb;
        if (u < 1024) { const int i = u >> 8, bb = u & 255; seq = 4 + i; head = bb & 7; qb = bb >> 3; }
        else { const int v = u - 1024, i = v >> 8, bb = v & 255; head = bb & 7; seq = 2 * i + ((bb >> 3) >> 4); qb = (bb >> 3) & 15; }
        const int seqbase = seq < 4 ? seq * 4096 : TP + (seq - 4) * 8192, S = seq < 4 ? 4096 : 8192;
        const int tok0 = seqbase + qb * 256;
        int lu_; asm volatile("v_mbcnt_lo_u32_b32 %0, -1, 0\n\tv_mbcnt_hi_u32_b32 %0, -1, %0" : "=v"(lu_));
        Ctx cxu = cx; cxu.tid = wid_s * 64 + lu_;
        attn_mla(cxu, QKVB + (size_t)tok0 * LDP + head * 256, QKVB + (size_t)seqbase * LDP + head * 256 + 96, QKVB + (size_t)seqbase * LDP + head * 256 + 192, S,
                 PROJ + (size_t)tok0 * LDP + 1536 + head * 64);
    }
    int la_; asm volatile("v_mbcnt_lo_u32_b32 %0, -1, 0\n\tv_mbcnt_hi_u32_b32 %0, -1, %0" : "=v"(la_));
    Ctx cxa = cx; cxa.tid = wid_s * 64 + la_;
    const int wid = wid_s;
    LAS unsigned char* stt = (LAS unsigned char*)smem;
    LAS unsigned char* vl = (LAS unsigned char*)smem + 69632 + wid * 10240;
    if (part != 1) for (int u = b; u < (T / 256) * 8; u += G) {
        const int head = u & 7, blk = u >> 3; const int tok0 = blk * 256;
        int seqbase, S; seq_of_tok(tok0, seqbase, S);
        attn_win_unit(cxa, PROJ, seqbase, S, tok0 - seqbase, head, stt, vl);
    }
}

__device__ __forceinline__ void attn_mem(const Ctx& cx, PP p, int l) {
    constexpr int KSTR = 272, VSTR = 288, KBUF = 256 * KSTR;
    static_assert(KBUF + 256 * VSTR <= LDS_BYTES, "LDS");
    bf16_t* QM = (bf16_t*)(p->ws + OFF_RA); const bf16_t* KVM = (const bf16_t*)(p->ws + OFF_KVM);
    const float* qgain = p->in[21] + l * 128; const float* kgain = p->in[22] + l * 128; const float qscale = 0.08838834764831845f * LOG2E;
    const int b = cx.bid, G = cx.nb, tid = cx.tid, wid = tid >> 6, lane = tid & 63, fr = lane & 15, fq = lane >> 4;
    LAS unsigned char* lds = (LAS unsigned char*)smem;
    const int nunits = (T / 256) * 4, per = (nunits + G - 1) / G;
    int curg = -1;
    for (int j = 0; j < per; ++j) {
        const int u = b * per + j; if (u >= nunits) break;
        int g, qb, seq;
        if (u < 512) { g = u >> 5; qb = u & 31; seq = 4 + (g >> 2); } else { const int v = u - 512; g = 16 + (v >> 4); qb = v & 15; seq = (g - 16) >> 2; }
        const int head = g & 3, seqbase = seq < 4 ? seq * 4096 : TP + (seq - 4) * 8192, tok0 = seqbase + qb * 256, mrow0 = seq * 256;
        if (g != curg) {
            __syncthreads();
            const bf16_t* Kb = KVM + (size_t)mrow0 * 1024 + head * 128; const bf16_t* Vb = Kb + 512;
#pragma unroll
            for (int i = 0; i < 8; ++i) { const int c = tid + i * 512, row = c >> 4, cc = c & 15;
                const u32x4 kv = *(const u32x4*)(Kb + (size_t)row * 1024 + cc * 8), vv = *(const u32x4*)(Vb + (size_t)row * 1024 + cc * 8);
                float kf_[8]; unpack8(kv, kf_); float ks_ = 0.f;
#pragma unroll
                for (int e = 0; e < 8; ++e) ks_ += kf_[e] * kf_[e];
                ks_ = sum16(ks_);
                const float krs_ = rsqrtf(ks_ * (1.0f / 128.0f) + EPS);
#pragma unroll
                for (int e = 0; e < 8; ++e) kf_[e] = kf_[e] * krs_ * kgain[cc * 8 + e];
                *(LAS u32x4*)(lds + row * KSTR + cc * 16) = pack8(kf_); *(LAS u32x4*)(lds + KBUF + row * VSTR + cc * 16) = vv; }
            __syncthreads();
            curg = g;
        }
        bf16_t* Q = QM + (size_t)tok0 * 512 + head * 128;
        bf16x8 qf[2][4];
#pragma unroll
        for (int qg = 0; qg < 2; ++qg) {
            const bf16_t* qp = Q + (size_t)(wid * 32 + qg * 16 + fr) * 512;
            float f[4][8]; float ss = 0.f;
#pragma unroll
            for (int kc = 0; kc < 4; ++kc) { unpack8(*(const u32x4*)(qp + kc * 32 + fq * 8), f[kc]);
#pragma unroll
                for (int i = 0; i < 8; ++i) ss += f[kc][i] * f[kc][i]; }
            ss += shx(ss, 16, lane); ss += shx(ss, 32, lane);
            const float rs = rsqrtf(ss * (1.0f / 128.0f) + EPS) * qscale;
#pragma unroll
            for (int kc = 0; kc < 4; ++kc) {
#pragma unroll
                for (int i = 0; i < 8; ++i) f[kc][i] = f[kc][i] * rs * qgain[kc * 32 + fq * 8 + i];
                qf[qg][kc] = __builtin_bit_cast(bf16x8, pack8(f[kc])); }
        }
        float mrun[2], lrun[2]; f32x4 o[2][8];
#pragma unroll
        for (int qg = 0; qg < 2; ++qg) { mrun[qg] = -1e30f; lrun[qg] = 0.f;
#pragma unroll
            for (int d = 0; d < 8; ++d) o[qg][d] = (f32x4){0.f, 0.f, 0.f, 0.f}; }
#pragma unroll 1
        for (int sub = 0; sub < 4; ++sub) {
            const LAS unsigned char* Kl = lds + sub * 64 * KSTR; const LAS unsigned char* Vl = lds + KBUF + sub * 64 * VSTR;
            f32x4 s[2][4];
#pragma unroll
            for (int qg = 0; qg < 2; ++qg)
#pragma unroll
                for (int kt = 0; kt < 4; ++kt) s[qg][kt] = (f32x4){0.f, 0.f, 0.f, 0.f};
#pragma unroll
            for (int kt = 0; kt < 4; ++kt)
#pragma unroll
                for (int kc = 0; kc < 4; ++kc) { const bf16x8 a = *(const LAS bf16x8*)(Kl + (kt * 16 + fr) * KSTR + (kc * 32 + fq * 8) * 2);
#pragma unroll
                    for (int qg = 0; qg < 2; ++qg) s[qg][kt] = MFMA16(a, qf[qg][kc], s[qg][kt]); }
            bf16x8 pb[2][2];
#pragma unroll
            for (int qg = 0; qg < 2; ++qg) {
                float mx = s[qg][0][0];
#pragma unroll
                for (int kt = 0; kt < 4; ++kt)
#pragma unroll
                    for (int jj = 0; jj < 4; ++jj) mx = fmaxf(mx, s[qg][kt][jj]);
                mx = fmaxf(mx, shx(mx, 16, lane)); mx = fmaxf(mx, shx(mx, 32, lane));
                const float mn = fmaxf(mrun[qg], mx), alpha = __builtin_amdgcn_exp2f(mrun[qg] - mn); mrun[qg] = mn;
                float rsum = 0.f;
#pragma unroll
                for (int kt = 0; kt < 4; ++kt)
#pragma unroll
                    for (int jj = 0; jj < 4; ++jj) { const float pv = __builtin_amdgcn_exp2f(s[qg][kt][jj] - mn); s[qg][kt][jj] = pv; rsum += pv; }
                lrun[qg] = lrun[qg] * alpha + rsum;
#pragma unroll
                for (int d = 0; d < 8; ++d) o[qg][d] = o[qg][d] * alpha;
#pragma unroll
                for (int t2 = 0; t2 < 2; ++t2) { u32x4 w; w.x = cvtpk(s[qg][2 * t2][0], s[qg][2 * t2][1]); w.y = cvtpk(s[qg][2 * t2][2], s[qg][2 * t2][3]);
                    w.z = cvtpk(s[qg][2 * t2 + 1][0], s[qg][2 * t2 + 1][1]); w.w = cvtpk(s[qg][2 * t2 + 1][2], s[qg][2 * t2 + 1][3]); pb[qg][t2] = __builtin_bit_cast(bf16x8, w); }
            }
#pragma unroll
            for (int t2 = 0; t2 < 2; ++t2)
#pragma unroll
                for (int d = 0; d < 8; ++d) {
                    const LAS unsigned char* vp = Vl + (t2 * 32 + fq * 4 + (fr >> 2)) * VSTR + (d * 16 + 4 * (fr & 3)) * 2;
                    const s16x4 lo = vtr(vp), hi = vtr(vp + 16 * VSTR);
                    const bf16x8 a = __builtin_shufflevector(lo, hi, 0, 1, 2, 3, 4, 5, 6, 7);
#pragma unroll
                    for (int qg = 0; qg < 2; ++qg) o[qg][d] = MFMA16(a, pb[qg][t2], o[qg][d]);
                }
        }
#pragma unroll
        for (int qg = 0; qg < 2; ++qg) {
            float lt = lrun[qg]; lt += shx(lt, 16, lane); lt += shx(lt, 32, lane);
            const float inv = 1.0f / lt;
            bf16_t* op = Q + (size_t)(wid * 32 + qg * 16 + fr) * 512 + fq * 4;
#pragma unroll
            for (int d = 0; d < 8; ++d) { u32x2 w; w.x = cvtpk(o[qg][d][0] * inv, o[qg][d][1] * inv); w.y = cvtpk(o[qg][d][2] * inv, o[qg][d][3] * inv); *(u32x2*)(op + d * 16) = w; }
        }
    }
}

__device__ __forceinline__ g8::GemmDesc mk_bf16(const bf16_t* A, int lda, const bf16_t* Bt, int ldb, int M, int N, int K, bf16_t* O, int ldc, int relu2, const float* ss = nullptr, int ssrow0 = 0) {
    g8::GemmDesc d; d.A = A; d.Bt = Bt; d.lda = lda; d.ldb = ldb; d.M = M; d.N = N; d.K = K; d.rev = 0; d.epi.mode = relu2; d.epi.eb = g8::EpiBf16{O, ldc, relu2, ss, ssrow0}; d.epi.er = g8::EpiRes{nullptr, nullptr, 0, nullptr, 0, nullptr, nullptr}; return d; }
__device__ __forceinline__ g8::GemmDesc mk_res(const bf16_t* A, int lda, const bf16_t* Bt, int ldb, int M, int N, int K, const float* x0, const float* x1, int split, float* out, int rowoff, bf16_t* xb, float* ss) {
    g8::GemmDesc d; d.A = A; d.Bt = Bt; d.lda = lda; d.ldb = ldb; d.M = M; d.N = N; d.K = K; d.rev = 0; d.epi.mode = 2; d.epi.eb = g8::EpiBf16{nullptr, 0, 0, nullptr, 0}; d.epi.er = g8::EpiRes{x0, x1, split, out, rowoff, xb, ss}; return d; }

#define FRESH_CX Ctx cx = cx0; { int l__; asm volatile("v_mbcnt_lo_u32_b32 %0, -1, 0\n\tv_mbcnt_hi_u32_b32 %0, -1, %0" : "=v"(l__)); cx.tid = wid_sg * 64 + l__; }
__device__ __forceinline__ void run_phase(const Ctx& cx0, PP p, int ph) {
    const int l = ph / NPH_LAYER; int q = ph % NPH_LAYER;
    const int wid_sg = cx0.tid;
#ifdef SPLIT_AB
    q = q <= 5 ? q : (q == 6 ? 19 : q - 1);
#endif
    bf16_t* W = (bf16_t*)(p->ws + OFF_W) + (size_t)l * W_LAYER_E;
    bf16_t* RA = (bf16_t*)(p->ws + OFF_RA); bf16_t* RB = (bf16_t*)(p->ws + OFF_RB);
    bf16_t* MM = (bf16_t*)(p->ws + OFF_MM); bf16_t* KVM = (bf16_t*)(p->ws + OFF_KVM);
    const float* x0 = l == 0 ? p->in[0] : p->out; const float* x1 = l == 0 ? p->in[1] : p->out + (size_t)TP * 1024;
    float* SS = (float*)(p->ws + OFF_SS);
    int ng = 0; g8::GemmDesc d0 = mk_bf16(nullptr, 0, nullptr, 0, 0, 0, 0, nullptr, 0, 0), d1 = d0;
    switch (q) {
    case 0: {  FRESH_CX;
        prologue(cx, p);
        xcast_rows(cx, p->in[0], p->in[1], TP, RB, SS, T);
        norm_rows(cx, p->in[2], p->in[3], 1024, p->in[18], MM, NMEMTOK);
        norm_rows(cx, p->in[2], p->in[3], 1024, p->in[18] + 1024, MM + (size_t)NMEMTOK * 1024, NMEMTOK);
        } break;
    case 1: ng = 1; d0 = mk_bf16(RB, 1024, W + WO_IN, 1024, T, 2048, 1024, RA, LDP, 0, SS, 0); break;
    case 2: { FRESH_CX; prep_a(cx, p, l); } break;
    case 3: ng = 1; d0 = mk_bf16(RA + 1536, LDP, W + WO_QKV, 384, T, 2048, 384, RB, LDP, 0); break;
    case 4: { FRESH_CX; prep_b(cx, p, l); } break;
#ifdef SPLIT_AB
    case 5: { FRESH_CX; attn_ab(cx, p, 1); } break;
    case 19: { FRESH_CX; attn_ab(cx, p, 2); } break;
#else
    case 5: { FRESH_CX; attn_ab(cx, p, 0); } break;
#endif
    case 6: { FRESH_CX; out_norm(cx, p, l); } break;
    case 7: ng = 1; d0 = mk_res(RA, LDP, W + WO_OUT, 1024, T, 1024, 1024, x0, x1, TP, p->out, 0, RB, SS); break;
    case 9: ng = 2; d0 = mk_bf16(RB, 1024, W + WO_MQ, 1024, T, 512, 1024, RA, 512, 0, SS, 0);
            d1 = mk_bf16(MM + (size_t)l * NMEMTOK * 1024, 1024, W + WO_MKV, 1024, NMEMTOK, 1024, 1024, KVM, 1024, 0); d1.rev = 1; break;
    case 10: { FRESH_CX; attn_mem(cx, p, l); } break;
    case 11: ng = 1; d0 = mk_res(RA, 512, W + WO_MO, 512, T, 1024, 512, p->out, p->out, T, p->out, 0, RB, SS); break;
    case 8: case 12: break;
    default: {
        const int c = (q - 13) >> 1, rowoff = c * 16384; ng = 1;
        if (((q - 13) & 1) == 0) d0 = mk_bf16(RB + (size_t)rowoff * 1024, 1024, W + WO_1, 1024, 16384, 4096, 1024, RA, 4096, 1, SS, rowoff);
        else d0 = mk_res(RA, 4096, W + WO_2, 4096, 16384, 1024, 4096, p->out, p->out, T, p->out, rowoff, RB, SS);
    } break;
    }
    int lg_; asm volatile("v_mbcnt_lo_u32_b32 %0, -1, 0\n\tv_mbcnt_hi_u32_b32 %0, -1, %0" : "=v"(lg_));
    Ctx cxg = cx0; cxg.tid = wid_sg * 64 + lg_;
#pragma unroll 1
    for (int gi = 0; gi < ng; ++gi) { const g8::GemmDesc d = gi == 0 ? d0 : d1; g8::gemm_phase(cxg, d.A, d.lda, d.Bt, d.ldb, d.M, d.N, d.K, d.epi, d.rev); }
}

__device__ __forceinline__ void grid_bar(unsigned* ctr, unsigned target, bool leader) {
    asm volatile("s_waitcnt vmcnt(0)" ::: "memory");
    __syncthreads();
    if (leader) {
        __builtin_amdgcn_fence(__ATOMIC_RELEASE, "agent");
        asm volatile("s_waitcnt vmcnt(0)" ::: "memory");
        (void)__hip_atomic_fetch_add(ctr, 1u, __ATOMIC_RELAXED, __HIP_MEMORY_SCOPE_AGENT);
        unsigned spins = 0;
        while (__hip_atomic_load(ctr, __ATOMIC_RELAXED, __HIP_MEMORY_SCOPE_AGENT) < target) { __builtin_amdgcn_s_sleep(1); if (++spins > (1u << 22)) break; }
        __builtin_amdgcn_fence(__ATOMIC_ACQUIRE, "agent");
        asm volatile("s_waitcnt vmcnt(0)" ::: "memory");
    }
    __syncthreads();
}

#define XB_TMO      128
#define XB_XCNT(j)  (256  + 64 * (j))
#define XB_XSUB(j)  (1280 + 64 * (j))
#define XB_XGEN(j)  (2304 + 64 * (j))
#define XB_TOP      3328
#define XB_TOPGEN   3392
#define XB_SPIN_CAP (1u << 20)
__device__ __forceinline__ unsigned xb_ld(unsigned* p)              { return __hip_atomic_load(p, __ATOMIC_RELAXED, __HIP_MEMORY_SCOPE_AGENT); }
__device__ __forceinline__ unsigned xb_add(unsigned* p, unsigned v) { return __hip_atomic_fetch_add(p, v, __ATOMIC_RELAXED, __HIP_MEMORY_SCOPE_AGENT); }
__device__ __forceinline__ unsigned xb_xcc_id() { return (unsigned)__builtin_amdgcn_s_getreg((3 << 11) | 20) & 0xFu; }
#define XB_SPIN(cond, bar) do { unsigned _sp = 0; while (cond) { __builtin_amdgcn_s_sleep(1); \
    if ((++_sp & 255u) == 0u) { if (xb_ld(&(bar)[XB_TMO])) break; if (_sp > XB_SPIN_CAP) { atomicAdd(&(bar)[XB_TMO], 1u); break; } } } } while (0)
__device__ __forceinline__ void xcd_bar(unsigned* bar, volatile LAS unsigned* st, bool leader, unsigned G) {
    asm volatile("s_waitcnt vmcnt(0)" ::: "memory");
    __syncthreads();
    if (leader) {
        const unsigned x = xb_xcc_id();
        __builtin_amdgcn_s_waitcnt(0);
        unsigned nloc = st[0], nx = st[1];
        if (nloc == 0u) {
            unsigned sum, cnt, mine, sp = 0u;
            for (;;) {
                sum = 0u; cnt = 0u; mine = 0u;
#pragma unroll
                for (unsigned j = 0; j < 16; ++j) { const unsigned c = xb_ld(&bar[XB_XCNT(j)]); sum += c; cnt += (c > 0u) ? 1u : 0u; mine = (j == x) ? c : mine; }
                if (sum == G) break;
                __builtin_amdgcn_s_sleep(1);
                if ((++sp & 255u) == 0u) { if (xb_ld(&bar[XB_TMO])) break; if (sp > XB_SPIN_CAP) { atomicAdd(&bar[XB_TMO], 1u); break; } }
            }
            nloc = mine > 0u ? mine : 1u; nx = cnt > 0u ? cnt : 1u; st[0] = nloc; st[1] = nx;
        }
        const unsigned old = xb_add(&bar[XB_XSUB(x)], 1u);
        const unsigned gen = old / nloc;
        if (old + 1u == (gen + 1u) * nloc) {
            __builtin_amdgcn_fence(__ATOMIC_RELEASE, "agent");
            asm volatile("s_waitcnt vmcnt(0)" ::: "memory");
            const unsigned og = xb_add(&bar[XB_TOP], 1u);
            const unsigned tg = og / nx;
            if (og + 1u == (tg + 1u) * nx) xb_add(&bar[XB_TOPGEN], 1u);
            else XB_SPIN(xb_ld(&bar[XB_TOPGEN]) == tg, bar);
            __builtin_amdgcn_fence(__ATOMIC_ACQUIRE, "agent");
            xb_add(&bar[XB_XGEN(x)], 1u);
            asm volatile("s_waitcnt vmcnt(0)" ::: "memory");
        } else {
            XB_SPIN(xb_ld(&bar[XB_XGEN(x)]) == gen, bar);
            __builtin_amdgcn_fence(__ATOMIC_ACQUIRE, "agent");
            asm volatile("s_waitcnt vmcnt(0)" ::: "memory");
        }
    }
    __syncthreads();
}

#ifndef PROBE_MULT
#define PROBE_MULT 0
#endif
#ifndef PROBE_MASK
#define PROBE_MASK 0
#endif
__global__ void __launch_bounds__(512) mega_fwd(Params pv) {
    cg::grid_group grid = cg::this_grid();
    const int ph_lo = pv.ph_lo, ph_hi = pv.ph_hi;
    int wid_s = __builtin_amdgcn_readfirstlane(threadIdx.x >> 6);
    unsigned long long t0 = 0, tacc = 0;
    unsigned nbar = 0;
    bool did_cg = false;
    volatile LAS unsigned* xst = (volatile LAS unsigned*)((LAS unsigned char*)smem + LDS_BYTES - 16);
    { int l0_; asm volatile("v_mbcnt_lo_u32_b32 %0, -1, 0\n\tv_mbcnt_hi_u32_b32 %0, -1, %0" : "=v"(l0_));
      if (wid_s == 0 && l0_ == 0) { xst[0] = 0u; xst[1] = 0u; (void)xb_add(&((unsigned*)(pv.ws + OFF_BAR))[XB_XCNT(xb_xcc_id())], 1u); }
      __syncthreads(); }
    for (int ph = ph_lo; ph < ph_hi; ++ph) {
        { const int qq = ph % NPH_LAYER; if (qq == 8 || qq == 12 || (qq == 0 && ph >= NPH_LAYER)) continue; }
        Ctx cx; cx.bid = blockIdx.x; cx.nb = gridDim.x;
        asm volatile("" : "+s"(wid_s));
        cx.tid = wid_s;
        asm volatile("" : "+s"(cx.bid)); asm volatile("" : "+s"(cx.nb));
        auto ka = __builtin_amdgcn_kernarg_segment_ptr();
        asm volatile("" : "+s"(ka));
        if (PROBE_MULT > 0 && ((PROBE_MASK >> (ph % NPH_LAYER)) & 1)) t0 = __builtin_amdgcn_s_memrealtime();
        run_phase(cx, (PP)ka, ph);
        if (ph + 1 < ph_hi) {
            if (!did_cg && ph_hi > 100000) { grid.sync(); did_cg = true; }
            else { ++nbar; int lane_; asm volatile("v_mbcnt_lo_u32_b32 %0, -1, 0\n\tv_mbcnt_hi_u32_b32 %0, -1, %0" : "=v"(lane_));
                   xcd_bar((unsigned*)(((PP)ka)->ws + OFF_BAR), xst, wid_s == 0 && lane_ == 0, (unsigned)cx.nb); }
        }
        if (PROBE_MULT > 0 && ((PROBE_MASK >> (ph % NPH_LAYER)) & 1)) tacc += __builtin_amdgcn_s_memrealtime() - t0;
    }
    if (PROBE_MULT > 0 && blockIdx.x == 0) {
        const unsigned long long te = __builtin_amdgcn_s_memrealtime();
        while (__builtin_amdgcn_s_memrealtime() - te < tacc * PROBE_MULT) __builtin_amdgcn_s_sleep(8);
    }
}

extern "C" void kernel_launch(void* const* d_in, const int* in_sizes, int n_in, void* d_out, int out_size, void* d_ws, size_t ws_size, hipStream_t stream) {
    static int grid = 0;
    if (grid == 0) {
        if (n_in != 27 || ws_size < WS_END) { fprintf(stderr, "kernel_launch: unexpected n_in %d / ws_size %zu (need %zu)\n", n_in, ws_size, (size_t)WS_END); grid = -1; return; }
        if (hipFuncSetAttribute((const void*)mega_fwd, hipFuncAttributeMaxDynamicSharedMemorySize, LDS_BYTES) != hipSuccess) { fprintf(stderr, "kernel_launch: hipFuncSetAttribute failed\n"); grid = -1; return; }
        int dev = 0, cus = 0, per_cu = 0;
        hipGetDevice(&dev); hipDeviceGetAttribute(&cus, hipDeviceAttributeMultiprocessorCount, dev);
        hipOccupancyMaxActiveBlocksPerMultiprocessor(&per_cu, (const void*)mega_fwd, 512, LDS_BYTES);
        (void)hipGetLastError();
        if (per_cu < 1) per_cu = 1;
        grid = cus * per_cu; if (grid > 256) grid = 256; grid &= ~7;
        if (grid < 8) grid = 8;
    }
    if (grid < 0) return;
    if (hipMemsetAsync((unsigned char*)d_ws + OFF_BAR, 0, 16384, stream) != hipSuccess) { fprintf(stderr, "kernel_launch: memset of the barrier words failed\n"); return; }
    Params p{};
    for (int i = 0; i < 27; ++i) p.in[i] = (const float*)d_in[i];
    p.out = (float*)d_out; p.ws = (unsigned char*)d_ws;
#if MK_ONE_LAUNCH
    p.ph_lo = 0; p.ph_hi = NPH;
    void* args[] = {&p};
    hipError_t e = hipLaunchCooperativeKernel((const void*)mega_fwd, dim3(grid), dim3(512), args, LDS_BYTES, stream);
    if (e != hipSuccess) fprintf(stderr, "cooperative launch failed: %s (grid %d)\n", hipGetErrorString(e), grid);
#else
    for (int ph = 0; ph < NPH; ++ph) { p.ph_lo = ph; p.ph_hi = ph + 1; hipLaunchKernelGGL(mega_fwd, dim3(grid), dim3(512), LDS_BYTES, stream, p); }
#endif
}
```
